# Optimizing an MI355X kernel written in HIP

```python
import math
import jax
import jax.numpy as jnp
from jax import lax
import numpy as np

D_MODEL = 1024
BATCH = 16
SEQ = 2048
DEPTH = 2
DEC_BATCH = 32
DEC_SEQ = 64
PAST_LEN = 2048

CHUNK = 64
EPS = 1e-6
D_INNER = 2 * D_MODEL
SSM_HEAD_DIM = 64
SSM_HEADS = D_INNER // SSM_HEAD_DIM
SSM_GROUPS = 4
SSM_HEADS_PER_GROUP = SSM_HEADS // SSM_GROUPS
D_STATE = 128
CONV_K = 4
CONV_CH = D_INNER + 2 * SSM_GROUPS * D_STATE
HEAD_DIM = 64
N_Q_HEADS = D_MODEL // HEAD_DIM
N_KV_HEADS = 4
Q_PER_KV = N_Q_HEADS // N_KV_HEADS
WINDOW = 128
WIN_CHUNKS = WINDOW // CHUNK
N_BUCKETS = 32
MAX_DISTANCE = 128
D_FF = math.ceil(8 * D_MODEL / 3 / 256) * 256
IN_SPLITS = (
    D_INNER,
    D_INNER + CONV_CH,
    D_INNER + CONV_CH + SSM_HEADS,
    D_INNER + CONV_CH + SSM_HEADS + N_Q_HEADS * HEAD_DIM,
    D_INNER + CONV_CH + SSM_HEADS + N_Q_HEADS * HEAD_DIM + N_KV_HEADS * HEAD_DIM,
    D_INNER + CONV_CH + SSM_HEADS + N_Q_HEADS * HEAD_DIM + 2 * N_KV_HEADS * HEAD_DIM,
    D_INNER + CONV_CH + SSM_HEADS + N_Q_HEADS * HEAD_DIM + 2 * N_KV_HEADS * HEAD_DIM + D_MODEL,
)
IN_COLS = IN_SPLITS[-1] + D_MODEL

kernel_name = "hybrid_ssd_swa_stream_step"


def rmsnorm(x, g):
    xf = x.astype(jnp.float32)
    y = xf * lax.rsqrt(jnp.mean(xf * xf, axis=-1, keepdims=True) + EPS)
    return (y * g.astype(jnp.float32)).astype(x.dtype)


def t5_bucket(rel):
    n = -rel
    half = N_BUCKETS // 2
    max_exact = half // 2
    ret = jnp.where(n < 0, half, 0)
    n = jnp.abs(n)
    nf = jnp.maximum(n, 1).astype(jnp.float32)
    large = max_exact + (jnp.log(nf / max_exact) / math.log(MAX_DISTANCE / max_exact)
                         * (half - max_exact)).astype(jnp.int32)
    large = jnp.minimum(large, half - 1)
    return ret + jnp.where(n < max_exact, n, large)


def causal_conv(u, prev, w, b):
    full = jnp.concatenate([prev.astype(u.dtype), u], axis=1)
    L = u.shape[1]
    out = full[:, 0:L] * w[0]
    for k in range(1, CONV_K):
        out = out + full[:, k:k + L] * w[k]
    return out + b, full[:, -(CONV_K - 1):]


def ssd_scan(xh, dt, a, bm, cm, state0):
    b, L = xh.shape[:2]
    lc = min(CHUNK, L)
    nc = L // lc

    def chunks(t):
        return jnp.swapaxes(t.reshape((b, nc, lc) + t.shape[2:]), 0, 1)

    xs = (chunks(xh.astype(jnp.float32) * dt[..., None]), chunks(dt * a),
          chunks(bm.astype(jnp.float32)), chunks(cm.astype(jnp.float32)))
    causal = jnp.tril(jnp.ones((lc, lc), dtype=bool))

    def step(state, inp):
        xdt, da, bc, cc = inp
        acum = jnp.cumsum(da, axis=1)
        seg = acum[:, :, None, :] - acum[:, None, :, :]
        decay = jnp.exp(jnp.where(causal[None, :, :, None], seg, -jnp.inf))
        decay = decay.reshape(b, lc, lc, SSM_GROUPS, SSM_HEADS_PER_GROUP)
        cb = jnp.einsum("blgn,bsgn->blsg", cc, bc)
        xg = xdt.reshape(b, lc, SSM_GROUPS, SSM_HEADS_PER_GROUP, SSM_HEAD_DIM)
        y_in = jnp.einsum("blsg,blsgh,bsghp->blghp", cb, decay, xg)
        sg = state.reshape(b, SSM_GROUPS, SSM_HEADS_PER_GROUP, SSM_HEAD_DIM, D_STATE)
        y_past = jnp.einsum("blgn,bghpn->blghp", cc, sg) * jnp.exp(acum).reshape(
            b, lc, SSM_GROUPS, SSM_HEADS_PER_GROUP)[..., None]
        tail = jnp.exp(acum[:, -1:] - acum).reshape(b, lc, SSM_GROUPS, SSM_HEADS_PER_GROUP)
        new = sg * jnp.exp(acum[:, -1]).reshape(b, SSM_GROUPS, SSM_HEADS_PER_GROUP)[..., None, None] \
            + jnp.einsum("blgn,blgh,blghp->bghpn", bc, tail, xg)
        return new.reshape(b, SSM_HEADS, SSM_HEAD_DIM, D_STATE), y_in + y_past

    final, ys = lax.scan(step, state0.astype(jnp.float32), xs)
    y = jnp.swapaxes(ys, 0, 1).reshape(b, L, SSM_HEADS, SSM_HEAD_DIM)
    return y, final


def band_rows(past, new, nc):
    rows = jnp.concatenate([past.astype(new.dtype), new], axis=1)
    if nc == 1:
        return rows[:, None]
    rc = rows.reshape((rows.shape[0], WIN_CHUNKS + nc, CHUNK) + rows.shape[2:])
    return jnp.concatenate([rc[:, m:m + nc] for m in range(WIN_CHUNKS + 1)], axis=2)


def sliding_attention(q, k, v, k_past, v_past, past_valid, q_norm_g, k_norm_g, sinks, rel_bias):
    b, L = q.shape[:2]
    lq = min(CHUNK, L)
    nc = L // lq
    lk = WINDOW + lq
    q = rmsnorm(q.reshape(b, L, N_KV_HEADS, Q_PER_KV, HEAD_DIM), q_norm_g)
    k = rmsnorm(k.reshape(b, L, N_KV_HEADS, HEAD_DIM), k_norm_g)
    v = v.reshape(b, L, N_KV_HEADS, HEAD_DIM)
    kb = band_rows(k_past, k, nc)
    vb = band_rows(v_past, v, nc)
    key_pos = jnp.arange(nc)[:, None] * lq + jnp.arange(lk)[None, :] - WINDOW
    valid = jnp.logical_or(key_pos >= 0, past_valid)
    rel = jnp.arange(lk)[None, :] - WINDOW - jnp.arange(lq)[:, None]
    bias = jnp.transpose(rel_bias[t5_bucket(rel)], (2, 0, 1)).reshape(
        N_KV_HEADS, Q_PER_KV, lq, lk).astype(jnp.float32)
    qb = q.reshape(b, nc, lq, N_KV_HEADS, Q_PER_KV, HEAD_DIM)
    s = jnp.einsum("bnqkgd,bnskd->bnkgqs", qb, kb).astype(jnp.float32) * (HEAD_DIM ** -0.5) + bias
    s = jnp.where(valid[None, :, None, None, None, :], s, -jnp.inf)
    sink = jnp.broadcast_to(sinks.astype(jnp.float32).reshape(1, 1, N_KV_HEADS, Q_PER_KV, 1, 1),
                            s.shape[:-1] + (1,))
    p = jax.nn.softmax(jnp.concatenate([s, sink], axis=-1), axis=-1)[..., :-1]
    o = jnp.einsum("bnkgqs,bnskd->bnqkgd", p.astype(v.dtype), vb)
    return o.reshape(b, L, N_Q_HEADS * HEAD_DIM), k, v


def trunk_layer(x, c, conv_prev, ssm_prev, k_past, v_past, past_valid,
                ada_w, ada_b, norm_mix_g, norm_ffn_g, w_in, conv_w, conv_b, dt_bias, a_log, d_skip,
                ssm_norm_g, q_norm_g, k_norm_g, sinks, rel_bias, w_br_ssm, w_br_attn, w_out,
                w_gate_up, w_down):
    b, L, _ = x.shape
    mod = jax.nn.silu(c) @ ada_w + ada_b
    sh_m, sc_m, gt_m, sh_f, sc_f, gt_f = jnp.split(mod[:, None, :], 6, axis=-1)
    h = rmsnorm(x, norm_mix_g) * (1 + sc_m) + sh_m
    z, xbc, dt_raw, q, k, v, g_ssm, g_attn = jnp.split(h @ w_in, IN_SPLITS, axis=-1)
    xbc, conv_new = causal_conv(xbc, conv_prev, conv_w, conv_b)
    xbc = jax.nn.silu(xbc)
    xs, bm, cm = jnp.split(xbc, [D_INNER, D_INNER + SSM_GROUPS * D_STATE], axis=-1)
    dt = jax.nn.softplus(dt_raw.astype(jnp.float32) + dt_bias.astype(jnp.float32))
    a = -jnp.exp(a_log.astype(jnp.float32))
    xh = xs.reshape(b, L, SSM_HEADS, SSM_HEAD_DIM)
    y, ssm_new = ssd_scan(xh, dt, a, bm.reshape(b, L, SSM_GROUPS, D_STATE),
                          cm.reshape(b, L, SSM_GROUPS, D_STATE), ssm_prev)
    y = (y.astype(x.dtype) + xh * d_skip[:, None]).reshape(b, L, D_INNER) * jax.nn.silu(z)
    y = rmsnorm(y.reshape(b, L, SSM_GROUPS, D_INNER // SSM_GROUPS),
                ssm_norm_g.reshape(SSM_GROUPS, D_INNER // SSM_GROUPS)).reshape(b, L, D_INNER)
    o, k_new, v_new = sliding_attention(q, k, v, k_past, v_past, past_valid,
                                        q_norm_g, k_norm_g, sinks, rel_bias)
    mixed = jax.nn.sigmoid(g_ssm) * (y @ w_br_ssm) + jax.nn.sigmoid(g_attn) * (o @ w_br_attn)
    x = x + gt_m * (mixed @ w_out)
    h2 = rmsnorm(x, norm_ffn_g) * (1 + sc_f) + sh_f
    gate, up = jnp.split(h2 @ w_gate_up, 2, axis=-1)
    x = x + gt_f * ((jax.nn.silu(gate) * up) @ w_down)
    return x, conv_new, ssm_new.astype(x.dtype), k_new, v_new


def setup_inputs(seed: int = 0) -> dict:
    key = jax.random.key(seed)
    ks = jax.random.split(key, 32)
    f32 = jnp.float32

    def nrm(i, shape, scale):
        return jax.random.normal(ks[i], shape, f32) * scale

    u = jax.random.uniform(ks[16], (DEPTH, SSM_HEADS), f32)
    dt0 = jnp.exp(u * (math.log(0.1) - math.log(1e-3)) + math.log(1e-3))
    return {
        "x_prompt": nrm(0, (BATCH, SEQ, D_MODEL), 1.0),
        "x_sample": nrm(1, (DEC_BATCH, DEC_SEQ, D_MODEL), 1.0),
        "cache_k": nrm(2, (DEPTH, DEC_BATCH, WINDOW, N_KV_HEADS, HEAD_DIM), 1.0),
        "cache_v": nrm(3, (DEPTH, DEC_BATCH, WINDOW, N_KV_HEADS, HEAD_DIM), 1.0),
        "state_conv": nrm(4, (DEPTH, DEC_BATCH, CONV_K - 1, CONV_CH), 1.0),
        "state_ssm": nrm(5, (DEPTH, DEC_BATCH, SSM_HEADS, SSM_HEAD_DIM, D_STATE), 0.3),
        "c_prompt": nrm(6, (BATCH, D_MODEL), 1.0),
        "c_sample": nrm(7, (DEC_BATCH, D_MODEL), 1.0),
        "rel_bias": nrm(8, (N_BUCKETS, N_Q_HEADS), 0.2),
        "ada_w": nrm(9, (DEPTH, D_MODEL, 6 * D_MODEL), 0.5 * D_MODEL ** -0.5),
        "ada_b": nrm(10, (DEPTH, 6 * D_MODEL), 0.02),
        "norm_mix_g": 1.0 + nrm(11, (DEPTH, D_MODEL), 0.05),
        "norm_ffn_g": 1.0 + nrm(12, (DEPTH, D_MODEL), 0.05),
        "w_in": nrm(13, (DEPTH, D_MODEL, IN_COLS), D_MODEL ** -0.5),
        "conv_w": nrm(14, (DEPTH, CONV_K, CONV_CH), CONV_K ** -0.5),
        "conv_b": nrm(15, (DEPTH, CONV_CH), 0.02),
        "dt_bias": dt0 + jnp.log(-jnp.expm1(-dt0)),
        "a_log": jnp.log(jax.random.uniform(ks[17], (DEPTH, SSM_HEADS), f32, 1.0, 16.0)),
        "d_skip": 1.0 + nrm(18, (DEPTH, SSM_HEADS), 0.05),
        "ssm_norm_g": 1.0 + nrm(19, (DEPTH, D_INNER), 0.05),
        "q_norm_g": 1.0 + nrm(20, (DEPTH, HEAD_DIM), 0.05),
        "k_norm_g": 1.0 + nrm(21, (DEPTH, HEAD_DIM), 0.05),
        "sinks": nrm(22, (DEPTH, N_Q_HEADS), 0.5),
        "w_br_ssm": nrm(23, (DEPTH, D_INNER, D_MODEL), D_INNER ** -0.5),
        "w_br_attn": nrm(24, (DEPTH, N_Q_HEADS * HEAD_DIM, D_MODEL), (N_Q_HEADS * HEAD_DIM) ** -0.5),
        "w_out": nrm(25, (DEPTH, D_MODEL, D_MODEL), D_MODEL ** -0.5),
        "w_gate_up": nrm(26, (DEPTH, D_MODEL, 2 * D_FF), D_MODEL ** -0.5),
        "w_down": nrm(27, (DEPTH, D_FF, D_MODEL), D_FF ** -0.5),
    }


def reference(x_prompt, x_sample, cache_k, cache_v, state_conv, state_ssm, c_prompt, c_sample,
              rel_bias, ada_w, ada_b, norm_mix_g, norm_ffn_g, w_in, conv_w, conv_b, dt_bias, a_log,
              d_skip, ssm_norm_g, q_norm_g, k_norm_g, sinks, w_br_ssm, w_br_attn, w_out,
              w_gate_up, w_down):
    bp = x_prompt.shape[0]
    zero_conv = jnp.zeros((bp, CONV_K - 1, CONV_CH), x_prompt.dtype)
    zero_ssm = jnp.zeros((bp, SSM_HEADS, SSM_HEAD_DIM, D_STATE), jnp.float32)
    zero_kv = jnp.zeros((bp, WINDOW, N_KV_HEADS, HEAD_DIM), x_prompt.dtype)
    xp, xs = x_prompt, x_sample
    conv_p, conv_s, ssm_p, ssm_s, k_p, k_s, v_p, v_s = [], [], [], [], [], [], [], []
    for l in range(DEPTH):
        lp = (ada_w[l], ada_b[l], norm_mix_g[l], norm_ffn_g[l], w_in[l], conv_w[l], conv_b[l],
              dt_bias[l], a_log[l], d_skip[l], ssm_norm_g[l], q_norm_g[l], k_norm_g[l], sinks[l],
              rel_bias, w_br_ssm[l], w_br_attn[l], w_out[l], w_gate_up[l], w_down[l])
        xp, cvp, ssp, kp, vp = trunk_layer(xp, c_prompt, zero_conv, zero_ssm, zero_kv, zero_kv, False, *lp)
        xs, cvs, sss, ksn, vsn = trunk_layer(xs, c_sample, state_conv[l], state_ssm[l],
                                             cache_k[l], cache_v[l], True, *lp)
        conv_p.append(cvp)
        conv_s.append(cvs)
        ssm_p.append(ssp)
        ssm_s.append(sss)
        k_p.append(kp[:, -WINDOW:])
        v_p.append(vp[:, -WINDOW:])
        k_s.append(ksn)
        v_s.append(vsn)
    return (xp, xs, jnp.stack(conv_p), jnp.stack(conv_s), jnp.stack(ssm_p), jnp.stack(ssm_s),
            jnp.stack(k_p), jnp.stack(k_s), jnp.stack(v_p), jnp.stack(v_s))
```

```cpp
#include <hip/hip_runtime.h>
#include <hip/hip_cooperative_groups.h>
#include <cstdio>
#include <cstdint>
namespace cg = cooperative_groups;

#define LAS __attribute__((address_space(3)))
typedef unsigned short bf16_t;
typedef short bf16x8 __attribute__((ext_vector_type(8)));
typedef short s16x4 __attribute__((ext_vector_type(4)));
typedef float f32x4 __attribute__((ext_vector_type(4)));
typedef unsigned u32x4 __attribute__((ext_vector_type(4)));
typedef unsigned u32x2 __attribute__((ext_vector_type(2)));
typedef float f32x2 __attribute__((ext_vector_type(2)));

constexpr int DM = 1024, NPB = 16, SEQ = 2048, NSB = 32, DSEQ = 64, MP = NPB * SEQ, MS = NSB * DSEQ, MTOT = MP + MS;
constexpr int DIN = 2048, CONVC = 3072, NH = 32, DSTATE = 128, NQH = 16, NKVH = 4, DFF = 2816, INCOLS = 8736;
constexpr int PN = 8960;
constexpr int C_Z = 0, C_XBC = 2048, C_Q = 5120, C_K = 6144, C_V = 6400, C_GS = 6656, C_GA = 7680, C_DT = 8704;
constexpr int NSEQ = NPB + NSB;
constexpr float EPS = 1e-6f;
constexpr int SLAB0_ROWS = 16384, SLAB1_ROWS = MTOT - SLAB0_ROWS;
constexpr int SLAB_MAXROWS = SLAB1_ROWS;

constexpr size_t O_Y = 0, O_CONVP = 35651584, O_CONVS = 35946496, O_SSMP = 36536320, O_SSMS = 44924928,
                 O_KP = 61702144, O_KS = 62750720, O_VP = 63799296, O_VS = 64847872;

constexpr size_t W_IN = 0, W_BR = 18350080, W_O = 24641536, W_GU = 26738688, W_D = 38273024, W_LAYER = 44040192;
constexpr size_t WS_MOD = 2 * W_LAYER, WS_SSQ = WS_MOD + 2359296, WS_H = WS_SSQ + 2359296, WS_PROJ = WS_H + (size_t)MTOT * DM * 2,
                 WS_CTL = WS_PROJ + (size_t)SLAB_MAXROWS * PN * 2, WS_END = WS_CTL + 16384;

constexpr int LDS_BYTES = 140 * 1024;

__device__ __forceinline__ unsigned pk2(float lo, float hi) { unsigned r; asm("v_cvt_pk_bf16_f32 %0, %1, %2" : "=v"(r) : "v"(lo), "v"(hi)); return r; }
__device__ __forceinline__ bf16_t f2bf(float f) { return (bf16_t)(pk2(f, 0.f) & 0xffffu); }
__device__ __forceinline__ float bflo(unsigned w) { return __uint_as_float(w << 16); }
__device__ __forceinline__ float bfhi(unsigned w) { return __uint_as_float(w & 0xffff0000u); }
__device__ __forceinline__ float bf2f(bf16_t h) { return __uint_as_float(((unsigned)h) << 16); }
__device__ __forceinline__ float sigmoidf_(float x) { return __builtin_amdgcn_rcpf(1.f + __expf(-x)); }
__device__ __forceinline__ float siluf_(float x) { return x * __builtin_amdgcn_rcpf(1.f + __expf(-x)); }
__device__ __forceinline__ float row16_sum(float v) {
    v += __builtin_bit_cast(float, __builtin_amdgcn_update_dpp(0, __builtin_bit_cast(int, v), 0xB1, 0xF, 0xF, true));
    v += __builtin_bit_cast(float, __builtin_amdgcn_update_dpp(0, __builtin_bit_cast(int, v), 0x4E, 0xF, 0xF, true));
    v += __builtin_bit_cast(float, __builtin_amdgcn_update_dpp(0, __builtin_bit_cast(int, v), 0x141, 0xF, 0xF, true));
    v += __builtin_bit_cast(float, __builtin_amdgcn_update_dpp(0, __builtin_bit_cast(int, v), 0x140, 0xF, 0xF, true));
    return v;
}
__device__ __forceinline__ f32x4 mfma16(bf16x8 a, bf16x8 b, f32x4 c) { return __builtin_amdgcn_mfma_f32_16x16x32_bf16(a, b, c, 0, 0, 0); }
#define LDS_WAIT() asm volatile("s_waitcnt lgkmcnt(0)" ::: "memory")
#define LBAR() do { asm volatile("s_waitcnt lgkmcnt(0)" ::: "memory"); __builtin_amdgcn_s_barrier(); asm volatile("" ::: "memory"); } while (0)

namespace pg8 {
constexpr int BM = 256, BK = 64, HALF = 128, HTB = HALF * BK * 2, STAGE_BYTES = 8 * HTB, NXCD = 8, WGM = 8;
__host__ __device__ __forceinline__ int lds_byte(int r, int c) { const int st = (r >> 4) * 2 + (c >> 5), rr = r & 15, cc = c & 31, ob = rr * 64 + cc * 2; return st * 1024 + (ob ^ (((ob >> 9) & 1) << 5)); }
__host__ __device__ __forceinline__ void stage_rc(int b, int& R, int& C) { const int st = b / 1024, sb = b % 1024, swz = sb ^ (((sb >> 9) & 1) << 5); R = (st >> 1) * 16 + swz / 64; C = (st & 1) * 32 + (swz % 64) / 2; }
__host__ __device__ __forceinline__ int perm32(int rho) { const int n = rho >> 4, i = rho & 15; return 8 * (i >> 2) + 4 * n + (i & 3); }

struct Unit { int pm, pn, part; };
struct Gemm { const bf16_t* A0; const bf16_t* A1; const bf16_t* A2; const bf16_t* B0; const bf16_t* B1; const bf16_t* B2; int K0, K1, K2; int lda, ldb;
    __device__ __forceinline__ const char* Ap(int part) const { return (const char*)A0 + (long)(part == 1) * ((const char*)A1 - (const char*)A0) + (long)(part == 2) * ((const char*)A2 - (const char*)A0); }
    __device__ __forceinline__ const char* Bp(int part) const { return (const char*)B0 + (long)(part == 1) * ((const char*)B1 - (const char*)B0) + (long)(part == 2) * ((const char*)B2 - (const char*)B0); }
    __device__ __forceinline__ int Kp(int part) const { return K0 + (part == 1) * (K1 - K0) + (part == 2) * (K2 - K0); } };

struct StaticOrder {
    int nM, nN, nwg, G, c, np, split_from;
    __device__ __forceinline__ void init(int nM_, int nN_, int G_, int c_, int np_, bool split_tail = false) { nM = nM_; nN = nN_; nwg = nM * nN; G = G_; c = c_; np = np_; split_from = split_tail ? (nwg / G) * G : nwg; }
    __device__ __forceinline__ bool next(int i, Unit& u) const {
        const int r = i / np; u.part = i - r * np;
        long L = (long)r * G + c;
        if (L >= split_from) { const long Ls = L - split_from; if (Ls >= 2L * (nwg - split_from)) return false; L = split_from + (Ls >> 1); u.part = 1 + (int)(Ls & 1); }
        if (L >= nwg) return false;
        int wgid = (int)L; { const int q = nwg / NXCD, rr = nwg % NXCD, xcd = wgid % NXCD, off = wgid / NXCD; wgid = (xcd < rr ? xcd * (q + 1) : rr * (q + 1) + (xcd - rr) * q) + off; }
        const int nig = WGM * nN, gid = wgid / nig, fm = gid * WGM, gsz = (nM - fm) < WGM ? (nM - fm) : WGM;
        u.pm = fm + ((wgid % nig) % gsz); u.pn = (wgid % nig) / gsz; return true;
    }
};

template <class Epi, bool GS = false>
__device__ __forceinline__ void gemm_phase(LAS unsigned char* lds, const Gemm g, const StaticOrder& S, const Epi& E, const int tid) {
    const int wid = __builtin_amdgcn_readfirstlane(tid >> 6), lane = tid & 63, wr = wid >> 2, wc = wid & 3, fr = lane & 15, fq = lane >> 4;
    unsigned voffA[2], voffB[2];
#pragma unroll
    for (int i = 0; i < 2; ++i) { int R, C; stage_rc(tid * 16 + i * 8192, R, C); const int Rb = Epi::PERM ? ((R & ~31) + perm32(R & 31)) : R;
        voffA[i] = (unsigned)(R * g.lda + C) * 2u; voffB[i] = (unsigned)(Rb * g.ldb + C) * 2u; }
    const size_t kstep = (size_t)(BK * 2);
    const size_t hstepA = (size_t)HALF * g.lda * 2, hstepB = (size_t)HALF * g.ldb * 2;
    const size_t tstepA = 2 * hstepA, tstepB = 2 * hstepB;
    const unsigned ldsw = (unsigned)wid * 1024u;
    const int aoff = lds_byte(wr * 64 + fr, fq * 8), boff = lds_byte(wc * 32 + fr, fq * 8);
#define PG8_SA(b, h) (((b) * 2 + (h)) * HTB)
#define PG8_SB(b, h) ((4 + (b) * 2 + (h)) * HTB)
#define PG8_STAGE(bufoff, gbase, voff) do { _Pragma("unroll") for (int _i = 0; _i < 2; ++_i) \
        __builtin_amdgcn_global_load_lds((const unsigned*)((const char*)(gbase) + (voff)[_i]), (LAS unsigned*)(lds + (bufoff) + ldsw + _i * 8192), 16, 0, 0); } while (0)
#define PG8_LDA(dst, b, h) do { _Pragma("unroll") for (int m = 0; m < 4; ++m) _Pragma("unroll") for (int k = 0; k < 2; ++k) dst[m][k] = *(const LAS bf16x8*)(lds + PG8_SA(b, h) + aoff + m * 2048 + k * 1024); } while (0)
#define PG8_LDB(dst, b, h) do { _Pragma("unroll") for (int n = 0; n < 2; ++n) _Pragma("unroll") for (int k = 0; k < 2; ++k) dst[n][k] = *(const LAS bf16x8*)(lds + PG8_SB(b, h) + boff + n * 2048 + k * 1024); } while (0)
#define PG8_MMA(ai, bj, At, Bt) do { __builtin_amdgcn_s_setprio(1); _Pragma("unroll") for (int m = 0; m < 4; ++m) _Pragma("unroll") for (int n = 0; n < 2; ++n) _Pragma("unroll") for (int k = 0; k < 2; ++k) \
        acc[ai][bj][m][n] = __builtin_amdgcn_mfma_f32_16x16x32_bf16(Bt[n][k], At[m][k], acc[ai][bj][m][n], 0, 0, 0); __builtin_amdgcn_s_setprio(0); } while (0)
#define PG8_WAIT_V(n) asm volatile("s_waitcnt vmcnt(" #n ")" ::: "memory")
#define PG8_WAIT_L(n) asm volatile("s_waitcnt lgkmcnt(" #n ")" ::: "memory")
#define PG8_BAR __builtin_amdgcn_s_barrier()
#define PG8_SCHED __builtin_amdgcn_sched_barrier(0)
    Unit cur, nxt; int ui = 0;
    if (!S.next(0, cur)) return;
    f32x4 acc[2][2][4][2];
#pragma unroll
    for (int a = 0; a < 2; ++a)
#pragma unroll
        for (int b = 0; b < 2; ++b)
#pragma unroll
            for (int m = 0; m < 4; ++m)
#pragma unroll
                for (int n = 0; n < 2; ++n) acc[a][b][m][n] = (f32x4){0.f, 0.f, 0.f, 0.f};
    bf16x8 At[4][2], B0[2][2], B1[2][2];
    const char* cA = g.Ap(cur.part) + (size_t)cur.pm * tstepA; const char* cB = g.Bp(cur.part) + (size_t)cur.pn * tstepB;
    PG8_STAGE(PG8_SB(0, 0), cB, voffB); PG8_STAGE(PG8_SB(0, 1), cB + hstepB, voffB); PG8_STAGE(PG8_SA(0, 0), cA, voffA); PG8_STAGE(PG8_SA(0, 1), cA + hstepA, voffA);
    if (wr == 1) PG8_BAR;
    PG8_WAIT_V(2); PG8_BAR;
    PG8_STAGE(PG8_SB(1, 0), cB + kstep, voffB); PG8_STAGE(PG8_SA(1, 0), cA + kstep, voffA); PG8_STAGE(PG8_SB(1, 1), cB + hstepB + kstep, voffB);
    PG8_WAIT_V(6); PG8_BAR;
    for (;;) {
        const bool has_next = S.next(ui + 1, nxt);
        const char* nA = has_next ? g.Ap(nxt.part) + (size_t)nxt.pm * tstepA : cA; const char* nB = has_next ? g.Bp(nxt.part) + (size_t)nxt.pn * tstepB : cB;
        const int nt = g.Kp(cur.part) / BK;
        const int seg = (GS && cur.part == 0) ? 8 : nt;
        for (int tg = 0; tg < nt; tg += seg) {
        for (int t = tg; t < tg + seg; t += 2) {
            const bool last = (t == nt - 2);
            const char* a1 = cA + (size_t)(t + 1) * kstep;
            const char* a2 = last ? nA : cA + (size_t)(t + 2) * kstep; const char* b2 = last ? nB : cB + (size_t)(t + 2) * kstep;
            const char* a3 = a2 + kstep; const char* b3 = b2 + kstep;
            PG8_LDB(B0, 0, 0); PG8_LDB(B1, 0, 1); PG8_SCHED; PG8_LDA(At, 0, 0); PG8_STAGE(PG8_SA(1, 1), a1 + hstepA, voffA);
            PG8_WAIT_V(8); PG8_WAIT_L(0); PG8_BAR; PG8_MMA(0, 0, At, B0); PG8_MMA(0, 1, At, B1); PG8_BAR; PG8_SCHED;
            PG8_LDA(At, 0, 1); PG8_STAGE(PG8_SB(0, 0), b2, voffB); PG8_STAGE(PG8_SB(0, 1), b2 + hstepB, voffB); PG8_STAGE(PG8_SA(0, 0), a2, voffA);
            PG8_WAIT_V(8); PG8_WAIT_L(0); PG8_BAR; PG8_MMA(1, 0, At, B0); PG8_MMA(1, 1, At, B1); PG8_BAR; PG8_SCHED;
            PG8_LDB(B0, 1, 0); PG8_LDB(B1, 1, 1); PG8_SCHED; PG8_LDA(At, 1, 0); PG8_STAGE(PG8_SA(0, 1), a2 + hstepA, voffA);
            PG8_WAIT_V(8); PG8_WAIT_L(0); PG8_BAR; PG8_MMA(0, 0, At, B0); PG8_MMA(0, 1, At, B1); PG8_BAR; PG8_SCHED;
            PG8_LDA(At, 1, 1); PG8_STAGE(PG8_SB(1, 0), b3, voffB); PG8_STAGE(PG8_SB(1, 1), b3 + hstepB, voffB); PG8_STAGE(PG8_SA(1, 0), a3, voffA);
            PG8_WAIT_V(8); PG8_WAIT_L(0); PG8_BAR; PG8_MMA(1, 0, At, B0); PG8_MMA(1, 1, At, B1); PG8_BAR; PG8_SCHED;
        }
        if constexpr (GS) {
            const bool ds = cur.part == 0;
            const LAS float* rt = (const LAS float*)(lds + STAGE_BYTES) + (ui >> 1) * 1024 + (tg >> 3) + (wr * 64 + fr) * 4;
#pragma unroll
            for (int a = 0; a < 2; ++a)
#pragma unroll
                for (int m = 0; m < 4; ++m) { const float f = ds ? rt[(a * HALF + m * 16) * 4] : 1.f;
#pragma unroll
                    for (int b = 0; b < 2; ++b)
#pragma unroll
                        for (int n = 0; n < 2; ++n) acc[a][b][m][n] = acc[a][b][m][n] * f; }
        }
        }
        if (wr == 0) PG8_BAR;
        E(acc, cur, wr, wc, fr, fq);
        if (!has_next) break;
#pragma unroll
        for (int a = 0; a < 2; ++a)
#pragma unroll
            for (int b = 0; b < 2; ++b)
#pragma unroll
                for (int m = 0; m < 4; ++m)
#pragma unroll
                    for (int n = 0; n < 2; ++n) acc[a][b][m][n] = (f32x4){0.f, 0.f, 0.f, 0.f};
        cur = nxt; cA = nA; cB = nB; ++ui;
        if (wr == 1) PG8_BAR;
    }
    PG8_WAIT_V(0);
    PG8_BAR;
#undef PG8_SA
#undef PG8_SB
#undef PG8_STAGE
#undef PG8_LDA
#undef PG8_LDB
#undef PG8_MMA
#undef PG8_WAIT_V
#undef PG8_WAIT_L
#undef PG8_BAR
#undef PG8_SCHED
}
}
using pg8::Unit;
constexpr int HALF = 128, BM = 256;

struct EpiProj {
    static constexpr bool PERM = true;
    bf16_t* O; int ldc;
    __device__ __forceinline__ void operator()(const f32x4 (&acc)[2][2][4][2], const Unit& u, int wr, int wc, int fr, int fq) const {
        const int row0 = u.pm * BM + wr * 64 + fr, col0 = u.pn * BM + wc * 32 + 8 * fq;
#pragma unroll
        for (int ai = 0; ai < 2; ++ai)
#pragma unroll
            for (int m = 0; m < 4; ++m) { bf16_t* rowp = O + (size_t)(row0 + ai * HALF + m * 16) * ldc + col0;
#pragma unroll
                for (int bj = 0; bj < 2; ++bj) { const f32x4 v0 = acc[ai][bj][m][0], v1 = acc[ai][bj][m][1];
                    u32x4 w; w.x = pk2(v0[0], v0[1]); w.y = pk2(v0[2], v0[3]); w.z = pk2(v1[0], v1[1]); w.w = pk2(v1[2], v1[3]);
                    *(u32x4*)(rowp + bj * HALF) = w; } }
    }
};
struct EpiBr {
    static constexpr bool PERM = true;
    const bf16_t* proj; bf16_t* mix;
    __device__ __forceinline__ void operator()(const f32x4 (&acc)[2][2][4][2], const Unit& u, int wr, int wc, int fr, int fq) const {
        const int row0 = u.pm * BM + wr * 64 + fr, col0 = u.pn * BM + wc * 32 + 8 * fq;
        const int gbase = u.part == 0 ? C_GS : C_GA;
#pragma unroll
        for (int ai = 0; ai < 2; ++ai) {
#pragma unroll
            for (int mp = 0; mp < 2; ++mp) {
            u32x4 gw[2][2], pw[2][2];
#pragma unroll
            for (int mm = 0; mm < 2; ++mm) { const int row = row0 + ai * HALF + (2 * mp + mm) * 16;
#pragma unroll
                for (int bj = 0; bj < 2; ++bj) { const int col = col0 + bj * HALF;
                    gw[mm][bj] = *(const u32x4*)(proj + (size_t)row * PN + gbase + col);
                    pw[mm][bj] = u.part == 1 ? *(const u32x4*)(mix + (size_t)row * DM + col) : (u32x4){0u, 0u, 0u, 0u}; } }
#pragma unroll
            for (int mm = 0; mm < 2; ++mm) { const int m = 2 * mp + mm; const int row = row0 + ai * HALF + m * 16;
#pragma unroll
                for (int bj = 0; bj < 2; ++bj) { const int col = col0 + bj * HALF;
                    const u32x4 g = gw[mm][bj], p = pw[mm][bj];
                    const f32x4 v0 = acc[ai][bj][m][0], v1 = acc[ai][bj][m][1];
                    float r[8];
                    r[0] = sigmoidf_(bflo(g.x)) * v0[0] + bflo(p.x); r[1] = sigmoidf_(bfhi(g.x)) * v0[1] + bfhi(p.x); r[2] = sigmoidf_(bflo(g.y)) * v0[2] + bflo(p.y); r[3] = sigmoidf_(bfhi(g.y)) * v0[3] + bfhi(p.y);
                    r[4] = sigmoidf_(bflo(g.z)) * v1[0] + bflo(p.z); r[5] = sigmoidf_(bfhi(g.z)) * v1[1] + bfhi(p.z); r[6] = sigmoidf_(bflo(g.w)) * v1[2] + bflo(p.w); r[7] = sigmoidf_(bfhi(g.w)) * v1[3] + bfhi(p.w);
                    u32x4 w; w.x = pk2(r[0], r[1]); w.y = pk2(r[2], r[3]); w.z = pk2(r[4], r[5]); w.w = pk2(r[6], r[7]);
                    *(u32x4*)(mix + (size_t)row * DM + col) = w; } }
            }
        }
    }
};
struct EpiRes {
    static constexpr bool PERM = false;
    const float* xin_p; const float* xin_s; float* out; const float* gate; int row_base;
    __device__ __forceinline__ void operator()(const f32x4 (&acc)[2][2][4][2], const Unit& u, int wr, int wc, int fr, int fq) const {
        const int col0 = u.pn * BM + wc * 32 + 4 * fq;
#pragma unroll
        for (int ai = 0; ai < 2; ++ai) {
            const int grb = row_base + u.pm * BM + ai * HALF + wr * 64;
            const int seq = grb < MP ? (grb >> 11) : NPB + ((grb - MP) >> 6);
            const float* gp = gate + (size_t)seq * (6 * DM) + col0;
            f32x4 gv[2][2];
#pragma unroll
            for (int bj = 0; bj < 2; ++bj)
#pragma unroll
                for (int n = 0; n < 2; ++n) gv[bj][n] = *(const f32x4*)(gp + bj * HALF + n * 16);
            if (u.part == 0) {
#pragma unroll
                for (int mp = 0; mp < 2; ++mp) {
                f32x4 xv[2][2][2];
#pragma unroll
                for (int mm = 0; mm < 2; ++mm) { const int gr = grb + (2 * mp + mm) * 16 + fr;
                    const float* xr = (gr < MP ? xin_p + (size_t)gr * DM : xin_s + (size_t)(gr - MP) * DM) + col0;
#pragma unroll
                    for (int bj = 0; bj < 2; ++bj)
#pragma unroll
                        for (int n = 0; n < 2; ++n) xv[mm][bj][n] = *(const f32x4*)(xr + bj * HALF + n * 16); }
#pragma unroll
                for (int mm = 0; mm < 2; ++mm) { const int m = 2 * mp + mm; const int gr = grb + m * 16 + fr; float* orow = out + (size_t)gr * DM + col0;
#pragma unroll
                    for (int bj = 0; bj < 2; ++bj)
#pragma unroll
                        for (int n = 0; n < 2; ++n) *(f32x4*)(orow + bj * HALF + n * 16) = xv[mm][bj][n] + gv[bj][n] * acc[ai][bj][m][n]; }
                }
            } else {
#pragma unroll
                for (int m = 0; m < 4; ++m) { const int gr = grb + m * 16 + fr; float* orow = out + (size_t)gr * DM + col0;
#pragma unroll
                    for (int bj = 0; bj < 2; ++bj)
#pragma unroll
                        for (int n = 0; n < 2; ++n) { const f32x4 d = gv[bj][n] * acc[ai][bj][m][n]; float* o = orow + bj * HALF + n * 16;
                            __hip_atomic_fetch_add(o + 0, d[0], __ATOMIC_RELAXED, __HIP_MEMORY_SCOPE_AGENT); __hip_atomic_fetch_add(o + 1, d[1], __ATOMIC_RELAXED, __HIP_MEMORY_SCOPE_AGENT);
                            __hip_atomic_fetch_add(o + 2, d[2], __ATOMIC_RELAXED, __HIP_MEMORY_SCOPE_AGENT); __hip_atomic_fetch_add(o + 3, d[3], __ATOMIC_RELAXED, __HIP_MEMORY_SCOPE_AGENT); } }
            }
        }
    }
};
struct EpiSwiglu {
    static constexpr bool PERM = true;
    bf16_t* act;
    __device__ __forceinline__ void operator()(const f32x4 (&acc)[2][2][4][2], const Unit& u, int wr, int wc, int fr, int fq) const {
        const int row0 = u.pm * BM + wr * 64 + fr, col0 = u.pn * HALF + wc * 32 + 8 * fq;
#pragma unroll
        for (int ai = 0; ai < 2; ++ai)
#pragma unroll
            for (int m = 0; m < 4; ++m) { const int row = row0 + ai * HALF + m * 16;
                const f32x4 g0 = acc[ai][0][m][0], g1 = acc[ai][0][m][1], u0 = acc[ai][1][m][0], u1 = acc[ai][1][m][1];
                u32x4 w; w.x = pk2(siluf_(g0[0]) * u0[0], siluf_(g0[1]) * u0[1]); w.y = pk2(siluf_(g0[2]) * u0[2], siluf_(g0[3]) * u0[3]);
                w.z = pk2(siluf_(g1[0]) * u1[0], siluf_(g1[1]) * u1[1]); w.w = pk2(siluf_(g1[2]) * u1[2], siluf_(g1[3]) * u1[3]);
                *(u32x4*)(act + (size_t)row * DFF + col0) = w; }
    }
};

struct Args { const float* in[28]; float* out; unsigned char* ws; };

__device__ __forceinline__ float wave_sum(float v) {
#pragma unroll
    for (int o = 1; o < 64; o <<= 1) v += __shfl_xor(v, o);
    return v;
}

__device__ __forceinline__ void transpose_item(const float* __restrict__ W, int ldw, int src_c0, int k0, bf16_t* __restrict__ WT, int ldk, int drow0, int dk0, LAS float* scr, int lane, const float* __restrict__ kscale = nullptr) {
    if (src_c0 >= 0) {
#pragma unroll
        for (int i = 0; i < 32; ++i) { const int kk = 2 * i + (lane >> 5); scr[kk * 33 + (lane & 31)] = W[(size_t)(k0 + kk) * ldw + src_c0 + (lane & 31)] * (kscale ? kscale[k0 + kk] : 1.f); }
    } else {
#pragma unroll 8
        for (int i = 0; i < 32; ++i) { const int kk = 2 * i + (lane >> 5); scr[kk * 33 + (lane & 31)] = 0.f; }
    }
    LDS_WAIT(); asm volatile("" ::: "memory");
    const int c = lane & 7;
#pragma unroll
    for (int j = 0; j < 4; ++j) { const int n = (lane >> 3) + 8 * j; const LAS float* s = scr + (8 * c) * 33 + n;
        u32x4 o; o.x = pk2(s[0 * 33], s[1 * 33]); o.y = pk2(s[2 * 33], s[3 * 33]); o.z = pk2(s[4 * 33], s[5 * 33]); o.w = pk2(s[6 * 33], s[7 * 33]);
        *(u32x4*)(WT + (size_t)(drow0 + n) * ldk + dk0 + k0 + 8 * c) = o; }
    LDS_WAIT(); asm volatile("" ::: "memory");
}

__device__ __forceinline__ void prologue_weights(const Args& a, LAS unsigned char* lds, int gw, int NGW, int wave, int lane) {
    LAS float* scr = (LAS float*)(lds + wave * 16384);
    constexpr int I_IN = 16 * (PN / 32), I_BS = 32 * 32, I_BA = 16 * 32, I_O = 16 * 32, I_GU = 16 * (2 * DFF / 32), I_D = (DFF / 64) * 32;
    constexpr int PER_LAYER = I_IN + I_BS + I_BA + I_O + I_GU + I_D;
    for (int it = gw; it < 2 * PER_LAYER; it += NGW) {
        const int l = it / PER_LAYER; int r = it - l * PER_LAYER;
        unsigned char* wl = a.ws + (size_t)l * W_LAYER;
        if (r < I_IN) { const int nblk = PN / 32, kb = r / nblk, nb = r % nblk, n0 = nb * 32;
            const int src = n0 < 5120 ? n0 : (n0 < 8704 ? n0 + 32 : (n0 < 8736 ? 5120 : -1));
            transpose_item(a.in[13] + (size_t)l * DM * INCOLS, INCOLS, src, kb * 64, (bf16_t*)(wl + W_IN), DM, n0, 0, scr, lane); continue; } r -= I_IN;
        if (r < I_BS) { const int kb = r / 32, nb = r % 32;
            transpose_item(a.in[23] + (size_t)l * DIN * DM, DM, nb * 32, kb * 64, (bf16_t*)(wl + W_BR), 3072, nb * 32, 0, scr, lane, a.in[19] + l * DIN); continue; } r -= I_BS;
        if (r < I_BA) { const int kb = r / 32, nb = r % 32;
            transpose_item(a.in[24] + (size_t)l * DM * DM, DM, nb * 32, kb * 64, (bf16_t*)(wl + W_BR), 3072, nb * 32, 2048, scr, lane); continue; } r -= I_BA;
        if (r < I_O) { const int kb = r / 32, nb = r % 32;
            transpose_item(a.in[25] + (size_t)l * DM * DM, DM, nb * 32, kb * 64, (bf16_t*)(wl + W_O), DM, nb * 32, 0, scr, lane); continue; } r -= I_O;
        if (r < I_GU) { const int nblk = 2 * DFF / 32, kb = r / nblk, nb = r % nblk, n0 = nb * 32, j = n0 >> 8, rr = n0 & 255;
            const int src = rr < 128 ? j * 128 + rr : DFF + j * 128 + (rr - 128);
            transpose_item(a.in[26] + (size_t)l * DM * 2 * DFF, 2 * DFF, src, kb * 64, (bf16_t*)(wl + W_GU), DM, n0, 0, scr, lane); continue; } r -= I_GU;
        { const int kb = r / 32, nb = r % 32;
            transpose_item(a.in[27] + (size_t)l * DFF * DM, DM, nb * 32, kb * 64, (bf16_t*)(wl + W_D), DFF, nb * 32, 0, scr, lane); }
    }
}

__device__ __forceinline__ void prologue_mod_item(const Args& a, LAS unsigned char* lds, int item, int tid) {
    const int l = item / 96, n0 = (item % 96) * 64;
    const float* W = a.in[9] + (size_t)l * DM * (6 * DM);
    LAS float* sl = (LAS float*)lds;
    const int col = tid & 63, kp = tid >> 6;
    f32x2 acc[NSEQ / 2];
#pragma unroll
    for (int s = 0; s < NSEQ / 2; ++s) acc[s] = (f32x2){0.f, 0.f};
    for (int half = 0; half < 2; ++half) {
        __syncthreads();
        for (int idx = tid; idx < 512 * NSEQ; idx += 512) { const int s = idx >> 9, kl = idx & 511, k = half * 512 + kl;
            const float v = s < NPB ? a.in[6][s * DM + k] : a.in[7][(s - NPB) * DM + k];
            sl[kl * NSEQ + s] = siluf_(v); }
        __syncthreads();
#pragma unroll 16
        for (int kk = 0; kk < 64; ++kk) { const int kl = kp * 64 + kk;
            const float w = W[(size_t)(half * 512 + kl) * (6 * DM) + n0 + col];
            const LAS f32x4* sp = (const LAS f32x4*)(sl + kl * NSEQ);
#pragma unroll
            for (int q = 0; q < NSEQ / 4; ++q) { const f32x4 sv = sp[q]; const f32x2 w2 = (f32x2){w, w};
                acc[2 * q] = __builtin_elementwise_fma((f32x2){sv[0], sv[1]}, w2, acc[2 * q]); acc[2 * q + 1] = __builtin_elementwise_fma((f32x2){sv[2], sv[3]}, w2, acc[2 * q + 1]); } }
    }
    __syncthreads();
#pragma unroll
    for (int s = 0; s < NSEQ; ++s) sl[(kp * NSEQ + s) * 64 + col] = acc[s >> 1][s & 1];
    __syncthreads();
    float* mod = (float*)(a.ws + WS_MOD) + (size_t)l * NSEQ * (6 * DM);
    for (int o = tid; o < NSEQ * 64; o += 512) { const int s = o >> 6, c = o & 63; float v = a.in[10][l * (6 * DM) + n0 + c];
#pragma unroll
        for (int p = 0; p < 8; ++p) v += sl[(p * NSEQ + s) * 64 + c];
        mod[(size_t)s * (6 * DM) + n0 + c] = v; }
    __syncthreads();
}

__device__ __forceinline__ void norm_mod_rows(const float* __restrict__ xp, const float* __restrict__ xs, const float* __restrict__ gvec, const float* __restrict__ mod, int ch_shift, int ch_scale,
                                              bf16_t* __restrict__ H, int row_base, int nrows, int gw, int NGW, int lane) {
    for (int r0 = gw; r0 < nrows; r0 += 2 * NGW) {
        const int r1 = r0 + NGW; const bool two = r1 < nrows;
        const int gr0 = row_base + r0, gr1 = row_base + (two ? r1 : r0);
        const float* xrow0 = gr0 < MP ? xp + (size_t)gr0 * DM : xs + (size_t)(gr0 - MP) * DM;
        const float* xrow1 = gr1 < MP ? xp + (size_t)gr1 * DM : xs + (size_t)(gr1 - MP) * DM;
        f32x4 v0[4], v1[4]; float s0 = 0.f, s1 = 0.f;
#pragma unroll
        for (int j = 0; j < 4; ++j) { v0[j] = ((const f32x4*)xrow0)[lane + 64 * j]; v1[j] = ((const f32x4*)xrow1)[lane + 64 * j]; }
#pragma unroll
        for (int j = 0; j < 4; ++j) { s0 += (v0[j][0] * v0[j][0] + v0[j][1] * v0[j][1]) + (v0[j][2] * v0[j][2] + v0[j][3] * v0[j][3]);
                                      s1 += (v1[j][0] * v1[j][0] + v1[j][1] * v1[j][1]) + (v1[j][2] * v1[j][2] + v1[j][3] * v1[j][3]); }
        const float rstd0 = rsqrtf(wave_sum(s0) * (1.f / DM) + EPS), rstd1 = rsqrtf(wave_sum(s1) * (1.f / DM) + EPS);
#pragma unroll
        for (int q = 0; q < 2; ++q) {
            if (q == 1 && !two) break;
            const int gr = q ? gr1 : gr0, r = q ? r1 : r0; const float rstd = q ? rstd1 : rstd0;
            const int seq = gr < MP ? (gr >> 11) : NPB + ((gr - MP) >> 6);
            const float* mrow = mod + (size_t)seq * (6 * DM);
            u32x2* o8 = (u32x2*)(H + (size_t)r * DM);
            f32x4 gq[4], scq[4], shq[4];
#pragma unroll
            for (int j = 0; j < 4; ++j) { const int ci = lane + 64 * j;
                gq[j] = ((const f32x4*)gvec)[ci]; scq[j] = ((const f32x4*)(mrow + ch_scale * DM))[ci]; shq[j] = ((const f32x4*)(mrow + ch_shift * DM))[ci]; }
#pragma unroll
            for (int j = 0; j < 4; ++j) { const int ci = lane + 64 * j;
                const f32x4 y = ((q ? v1[j] : v0[j]) * rstd) * gq[j] * (scq[j] + 1.f) + shq[j];
                u32x2 w; w.x = pk2(y[0], y[1]); w.y = pk2(y[2], y[3]); o8[ci] = w; }
        }
    }
}

__device__ __forceinline__ void ynorm_rows(bf16_t* proj, const float* ssq, const float* gvec, int nrows, int gw, int NGW, int lane) {
    for (int r0 = gw; r0 < nrows; r0 += 2 * NGW) {
        const int r1 = (r0 + NGW < nrows) ? r0 + NGW : r0; const bool two = r1 != r0;
        float q0 = lane < 32 ? ssq[(size_t)r0 * NH + lane] : 0.f, q1 = lane < 32 ? ssq[(size_t)r1 * NH + lane] : 0.f;
        u32x4* row0 = (u32x4*)(proj + (size_t)r0 * PN); u32x4* row1 = (u32x4*)(proj + (size_t)r1 * PN);
        u32x4 w0[4], w1[4];
#pragma unroll
        for (int j = 0; j < 4; ++j) { w0[j] = row0[j * 64 + lane]; w1[j] = row1[j * 64 + lane]; }
        q0 += __shfl_xor(q0, 1); q0 += __shfl_xor(q0, 2); q0 += __shfl_xor(q0, 4);
        q1 += __shfl_xor(q1, 1); q1 += __shfl_xor(q1, 2); q1 += __shfl_xor(q1, 4);
        const float rs0 = rsqrtf(q0 * (1.f / 512.f) + EPS), rs1 = rsqrtf(q1 * (1.f / 512.f) + EPS);
#pragma unroll
        for (int j = 0; j < 4; ++j) { const int ci = j * 64 + lane;
            const f32x4 g0 = ((const f32x4*)gvec)[2 * ci], g1 = ((const f32x4*)gvec)[2 * ci + 1];
            { const float rj = __shfl(rs0, j * 8); const u32x4 w = w0[j];
              u32x4 o; o.x = pk2(bflo(w.x) * rj * g0[0], bfhi(w.x) * rj * g0[1]); o.y = pk2(bflo(w.y) * rj * g0[2], bfhi(w.y) * rj * g0[3]);
              o.z = pk2(bflo(w.z) * rj * g1[0], bfhi(w.z) * rj * g1[1]); o.w = pk2(bflo(w.w) * rj * g1[2], bfhi(w.w) * rj * g1[3]); row0[ci] = o; }
            { const float rj = __shfl(rs1, j * 8); const u32x4 w = w1[j];
              u32x4 o; o.x = pk2(bflo(w.x) * rj * g0[0], bfhi(w.x) * rj * g0[1]); o.y = pk2(bflo(w.y) * rj * g0[2], bfhi(w.y) * rj * g0[3]);
              o.z = pk2(bflo(w.z) * rj * g1[0], bfhi(w.z) * rj * g1[1]); o.w = pk2(bflo(w.w) * rj * g1[2], bfhi(w.w) * rj * g1[3]); if (two) row1[ci] = o; }
        }
    }
}

__device__ __forceinline__ void convbc_item(const Args& a, int layer, bool is_sample, int b, int cg32, int seq_row0, bf16_t* proj, const int tid) {
    const int oc = is_sample ? (tid & 15) : (tid & 3), ts = is_sample ? (tid >> 4) : (tid >> 2);
    const int L = is_sample ? DSEQ : SEQ, seglen = is_sample ? 2 : 16;
    const bool act = true;
    const int ch = DIN + (is_sample ? cg32 * 128 : cg32 * 32) + oc * 8;
    const int t0 = ts * seglen;
    u32x4 rw[19];
    float cw[4][8], cb[8];
    if (act) {
        const float* wp = a.in[14] + (size_t)layer * 4 * CONVC + ch; const float* bp = a.in[15] + (size_t)layer * CONVC + ch;
#pragma unroll
        for (int k = 0; k < 4; ++k) { const f32x4 w0 = *(const f32x4*)(wp + k * CONVC), w1 = *(const f32x4*)(wp + k * CONVC + 4);
            cw[k][0] = w0[0]; cw[k][1] = w0[1]; cw[k][2] = w0[2]; cw[k][3] = w0[3]; cw[k][4] = w1[0]; cw[k][5] = w1[1]; cw[k][6] = w1[2]; cw[k][7] = w1[3]; }
        const f32x4 b0 = *(const f32x4*)bp, b1 = *(const f32x4*)(bp + 4);
        cb[0] = b0[0]; cb[1] = b0[1]; cb[2] = b0[2]; cb[3] = b0[3]; cb[4] = b1[0]; cb[5] = b1[1]; cb[6] = b1[2]; cb[7] = b1[3];
#pragma unroll
        for (int r = 0; r < 19; ++r) {
            const int tt = t0 - 3 + r;
            if (r < 3 + seglen) {
                if (tt >= 0) rw[r] = *(const u32x4*)(proj + (size_t)(seq_row0 + tt) * PN + C_XBC + ch);
                else if (is_sample) { const float* pp = a.in[4] + ((size_t)(layer * NSB + b) * 3 + (3 + tt)) * CONVC + ch;
                    const f32x4 p0 = *(const f32x4*)pp, p1 = *(const f32x4*)(pp + 4);
                    rw[r].x = pk2(p0[0], p0[1]); rw[r].y = pk2(p0[2], p0[3]); rw[r].z = pk2(p1[0], p1[1]); rw[r].w = pk2(p1[2], p1[3]); }
                else rw[r] = (u32x4){0u, 0u, 0u, 0u};
            }
        }
    }
    __syncthreads();
    if (act) {
        float* nc = a.out + (is_sample ? O_CONVS + (size_t)(layer * NSB + b) * 3 * CONVC : O_CONVP + (size_t)(layer * NPB + b) * 3 * CONVC) + ch;
#pragma unroll
        for (int t = 0; t < 16; ++t) {
            if (t < seglen) {
                float o[8];
#pragma unroll
                for (int i = 0; i < 8; ++i) o[i] = cb[i];
#pragma unroll
                for (int k = 0; k < 4; ++k) { const u32x4 w = rw[t + k];
                    o[0] += cw[k][0] * bflo(w.x); o[1] += cw[k][1] * bfhi(w.x); o[2] += cw[k][2] * bflo(w.y); o[3] += cw[k][3] * bfhi(w.y);
                    o[4] += cw[k][4] * bflo(w.z); o[5] += cw[k][5] * bfhi(w.z); o[6] += cw[k][6] * bflo(w.w); o[7] += cw[k][7] * bfhi(w.w); }
                u32x4 w; w.x = pk2(siluf_(o[0]), siluf_(o[1])); w.y = pk2(siluf_(o[2]), siluf_(o[3])); w.z = pk2(siluf_(o[4]), siluf_(o[5])); w.w = pk2(siluf_(o[6]), siluf_(o[7]));
                *(u32x4*)(proj + (size_t)(seq_row0 + t0 + t) * PN + C_XBC + ch) = w;
                const int tl = t0 + t - (L - 3);
                if (tl >= 0) { const u32x4 rr = rw[t + 3]; float* q = nc + (size_t)tl * CONVC;
                    *(f32x4*)q = (f32x4){bflo(rr.x), bfhi(rr.x), bflo(rr.y), bfhi(rr.y)}; *(f32x4*)(q + 4) = (f32x4){bflo(rr.z), bfhi(rr.z), bflo(rr.w), bfhi(rr.w)}; }
            }
        }
    }
}

constexpr int P64 = 144, P128 = 272;
constexpr int L_XST = 0, L_G = L_XST + 64 * P64, L_CM = L_G + 64 * P64, L_BM = L_CM + 64 * P128, L_BWT = L_BM + 64 * P128,
              L_ST = L_BWT + 128 * P64, L_ZT = L_ST + 64 * P128, L_XRAW = L_ZT + 64 * P64, L_DT = L_XRAW + 68 * P64, L_AC = L_DT + 8192,
              L_SSQ = L_AC + 8192, L_SSQA = L_SSQ + 512, L_SSD_END = L_SSQA + 8192;
static_assert(L_SSD_END <= LDS_BYTES - 256, "ssd lds");
constexpr unsigned SSD_STEP = 64u * PN * 2u;

__device__ __forceinline__ void ssd_item(const Args& a, LAS unsigned char* lds, int layer, bool is_sample, int b, int h, int seq_row0, int nchunks,
                                         bf16_t* proj, float* ssq, const int tid) {
    const int wave = __builtin_amdgcn_readfirstlane(tid >> 6), lane = tid & 63, fr = lane & 15, fq = lane >> 4;
    const int grp = h >> 3, tok = tid >> 3, oct = tid & 7;
    float cw[4][8], cb[8];
    {
        const int chx = h * 64 + wave * 8;
        const float* wp = a.in[14] + (size_t)layer * 4 * CONVC + chx; const float* bp = a.in[15] + (size_t)layer * CONVC + chx;
#pragma unroll
        for (int k = 0; k < 4; ++k) { const f32x4 w0 = *(const f32x4*)(wp + k * CONVC), w1 = *(const f32x4*)(wp + k * CONVC + 4);
            cw[k][0] = w0[0]; cw[k][1] = w0[1]; cw[k][2] = w0[2]; cw[k][3] = w0[3]; cw[k][4] = w1[0]; cw[k][5] = w1[1]; cw[k][6] = w1[2]; cw[k][7] = w1[3]; }
        const f32x4 b0 = *(const f32x4*)bp, b1 = *(const f32x4*)(bp + 4);
        cb[0] = b0[0]; cb[1] = b0[1]; cb[2] = b0[2]; cb[3] = b0[3]; cb[4] = b1[0]; cb[5] = b1[1]; cb[6] = b1[2]; cb[7] = b1[3];
    }
    const float dtb = a.in[16][layer * NH + h], Aneg = -__expf(a.in[17][layer * NH + h]), dsk = a.in[18][layer * NH + h];
    const int pb = wave >> 1, nb0 = (wave & 1) * 4, rb = wave >> 1;
    f32x4 st[4];
    float* ssm_out = a.out + (is_sample ? O_SSMS + ((size_t)(layer * NSB + b) * NH + h) * 8192 : O_SSMP + ((size_t)(layer * NPB + b) * NH + h) * 8192);
    if (is_sample) {
        const float* sp = a.in[5] + ((size_t)(layer * NSB + b) * NH + h) * 8192;
#pragma unroll
        for (int i = 0; i < 4; ++i)
            st[i] = *(const f32x4*)(sp + (16 * pb + fr) * DSTATE + 16 * (nb0 + i) + 4 * fq);
    } else {
#pragma unroll
        for (int i = 0; i < 4; ++i) st[i] = (f32x4){0.f, 0.f, 0.f, 0.f};
    }
    LAS float* dt_all = (LAS float*)(lds + L_DT); LAS float* ac_all = (LAS float*)(lds + L_AC);
    LAS float* ssqp = (LAS float*)(lds + L_SSQ);
    const char* pbase = (const char*)proj;
    const unsigned off_x = (unsigned)((seq_row0 + tok) * PN + C_XBC + h * 64 + oct * 8) * 2u;
    const unsigned off_b = (unsigned)((seq_row0 + (tid >> 4) * 2) * PN + C_XBC + DIN + grp * DSTATE + (tid & 15) * 8) * 2u;
    const unsigned off_z = (unsigned)((seq_row0 + tok) * PN + C_Z + h * 64 + oct * 8) * 2u;
    u32x4 xv, xh = (u32x4){0u, 0u, 0u, 0u}, bv0, bv1, cv0, cv1, zv;
    xv = *(const u32x4*)(pbase + off_x); bv0 = *(const u32x4*)(pbase + off_b); bv1 = *(const u32x4*)(pbase + off_b + PN * 2); cv0 = *(const u32x4*)(pbase + off_b + 1024); cv1 = *(const u32x4*)(pbase + off_b + PN * 2 + 1024);
    zv = *(const u32x4*)(pbase + off_z);
    {
        bf16_t dr[4];
#pragma unroll
        for (int q = 0; q < 4; ++q) { const int cc = wave + 8 * q; dr[q] = cc < nchunks ? proj[(size_t)(seq_row0 + cc * 64 + lane) * PN + C_DT + h] : (bf16_t)0; }
#pragma unroll
        for (int q = 0; q < 4; ++q) { const int cc = wave + 8 * q;
            if (cc < nchunks) {
                const float x = bf2f(dr[q]) + dtb;
                const float dt = x > 20.f ? x : log1pf(__expf(x));
                float sc = dt * Aneg;
#pragma unroll
                for (int off = 1; off < 64; off <<= 1) { const float v = __shfl_up(sc, off); if (lane >= off) sc += v; }
                dt_all[cc * 64 + lane] = dt; ac_all[cc * 64 + lane] = sc * 1.4426950408889634f; } }
    }
    if (is_sample && tid < 24) { const float* pp = a.in[4] + ((size_t)(layer * NSB + b) * 3 + tok) * CONVC + h * 64 + oct * 8;
        const f32x4 p0 = *(const f32x4*)pp, p1 = *(const f32x4*)(pp + 4);
        xh.x = pk2(p0[0], p0[1]); xh.y = pk2(p0[2], p0[3]); xh.z = pk2(p1[0], p1[1]); xh.w = pk2(p1[2], p1[3]); }
#pragma unroll 1
    for (int c = 0; c < nchunks; ++c) {
        const unsigned cs = (unsigned)c * SSD_STEP;
        const LAS float* dtv = dt_all + c * 64; const LAS float* acv = ac_all + c * 64;
        *(LAS u32x4*)(lds + L_XRAW + (3 + tok) * P64 + oct * 16) = xv;
        if (tid < 24) *(LAS u32x4*)(lds + L_XRAW + tok * P64 + oct * 16) = xh;
        { const int oc = tid & 15, tk = (tid >> 4) * 2;
          *(LAS u32x4*)(lds + L_BM + tk * P128 + oc * 16) = bv0; *(LAS u32x4*)(lds + L_BM + (tk + 1) * P128 + oc * 16) = bv1;
          *(LAS u32x4*)(lds + L_CM + tk * P128 + oc * 16) = cv0; *(LAS u32x4*)(lds + L_CM + (tk + 1) * P128 + oc * 16) = cv1; }
        {
            const u32x4 yv = *(const LAS u32x4*)(lds + L_ZT + tok * P64 + oct * 16);
            *(LAS u32x4*)(lds + L_ZT + tok * P64 + oct * 16) = zv;
            if (c > 0) *(u32x4*)(const_cast<char*>(pbase) + off_z + cs - SSD_STEP) = yv; }
#pragma unroll
        for (int i = 0; i < 4; ++i) { u32x2 w; w.x = pk2(st[i][0], st[i][1]); w.y = pk2(st[i][2], st[i][3]);
            *(LAS u32x2*)(lds + L_ST + (16 * pb + fr) * P128 + (16 * (nb0 + i) + 4 * fq) * 2) = w; }
        LBAR();
        const u32x4 bo0 = bv0, bo1 = bv1;
        if (c + 1 < nchunks) {
            const unsigned cn = cs + SSD_STEP;
            xv = *(const u32x4*)(pbase + off_x + cn); if (tid < 24) xh = *(const u32x4*)(pbase + off_x + cn - 3u * PN * 2u);
            bv0 = *(const u32x4*)(pbase + off_b + cn); bv1 = *(const u32x4*)(pbase + off_b + cn + PN * 2); cv0 = *(const u32x4*)(pbase + off_b + cn + 1024); cv1 = *(const u32x4*)(pbase + off_b + cn + PN * 2 + 1024);
            zv = *(const u32x4*)(pbase + off_z + cn);
        }
        {
            float o[8];
#pragma unroll
            for (int i = 0; i < 8; ++i) o[i] = cb[i];
#pragma unroll
            for (int k = 0; k < 4; ++k) { const u32x4 w = *(const LAS u32x4*)(lds + L_XRAW + (lane + k) * P64 + wave * 16);
                o[0] += cw[k][0] * bflo(w.x); o[1] += cw[k][1] * bfhi(w.x); o[2] += cw[k][2] * bflo(w.y); o[3] += cw[k][3] * bfhi(w.y);
                o[4] += cw[k][4] * bflo(w.z); o[5] += cw[k][5] * bfhi(w.z); o[6] += cw[k][6] * bflo(w.w); o[7] += cw[k][7] * bfhi(w.w); }
#pragma unroll
            for (int i = 0; i < 8; ++i) *(LAS bf16_t*)(lds + L_XST + (wave * 8 + i) * P64 + lane * 2) = f2bf(siluf_(o[i]));
        }
        {
            const int oc = tid & 15, tk = (tid >> 4) * 2;
            const float a63s = acv[63]; const float wa = dtv[tk] * __builtin_amdgcn_exp2f(a63s - acv[tk]), wb = dtv[tk + 1] * __builtin_amdgcn_exp2f(a63s - acv[tk + 1]);
            LAS unsigned char* d = lds + L_BWT + (oc * 8) * P64 + ((((tk >> 3) ^ ((oc >> 1) & 7)) << 4) | ((tk * 2) & 15));
            *(LAS unsigned*)(d + 0 * P64) = pk2(bflo(bo0.x) * wa, bflo(bo1.x) * wb); *(LAS unsigned*)(d + 1 * P64) = pk2(bfhi(bo0.x) * wa, bfhi(bo1.x) * wb);
            *(LAS unsigned*)(d + 2 * P64) = pk2(bflo(bo0.y) * wa, bflo(bo1.y) * wb); *(LAS unsigned*)(d + 3 * P64) = pk2(bfhi(bo0.y) * wa, bfhi(bo1.y) * wb);
            *(LAS unsigned*)(d + 4 * P64) = pk2(bflo(bo0.z) * wa, bflo(bo1.z) * wb); *(LAS unsigned*)(d + 5 * P64) = pk2(bfhi(bo0.z) * wa, bfhi(bo1.z) * wb);
            *(LAS unsigned*)(d + 6 * P64) = pk2(bflo(bo0.w) * wa, bflo(bo1.w) * wb); *(LAS unsigned*)(d + 7 * P64) = pk2(bfhi(bo0.w) * wa, bfhi(bo1.w) * wb);
        }
        {
            float al[4];
#pragma unroll
            for (int j = 0; j < 4; ++j) al[j] = acv[16 * rb + 4 * fq + j];
#pragma unroll
            for (int ci = 0; ci < 2; ++ci) { const int cbk = (wave & 1) * 2 + ci; f32x4 acc = (f32x4){0.f, 0.f, 0.f, 0.f};
#pragma unroll
                for (int ks = 0; ks < 4; ++ks) { const bf16x8 av = *(const LAS bf16x8*)(lds + L_CM + (16 * rb + fr) * P128 + (32 * ks + 8 * fq) * 2);
                    const bf16x8 bv = *(const LAS bf16x8*)(lds + L_BM + (16 * cbk + fr) * P128 + (32 * ks + 8 * fq) * 2); acc = mfma16(av, bv, acc); }
                const int s = 16 * cbk + fr; const float as = acv[s], ds = dtv[s];
#pragma unroll
                for (int j = 0; j < 4; ++j) { const int l = 16 * rb + 4 * fq + j;
                    const float gv = (s <= l) ? acc[j] * __builtin_amdgcn_exp2f(al[j] - as) * ds : 0.f;
                    *(LAS bf16_t*)(lds + L_G + l * P64 + s * 2) = f2bf(gv); } }
        }
        LBAR();
        {
            float sq[4] = {0.f, 0.f, 0.f, 0.f}, el[4];
#pragma unroll
            for (int j = 0; j < 4; ++j) el[j] = __builtin_amdgcn_exp2f(acv[16 * rb + 4 * fq + j]);
#pragma unroll
            for (int ci = 0; ci < 2; ++ci) { const int cbk = (wave & 1) * 2 + ci; f32x4 acc = (f32x4){0.f, 0.f, 0.f, 0.f}, acp = (f32x4){0.f, 0.f, 0.f, 0.f};
#pragma unroll
                for (int ks = 0; ks < 2; ++ks) { const bf16x8 av = *(const LAS bf16x8*)(lds + L_G + (16 * rb + fr) * P64 + (32 * ks + 8 * fq) * 2);
                    const bf16x8 bv = *(const LAS bf16x8*)(lds + L_XST + (16 * cbk + fr) * P64 + (32 * ks + 8 * fq) * 2); acc = mfma16(av, bv, acc); }
#pragma unroll
                for (int ks = 0; ks < 4; ++ks) { const bf16x8 av = *(const LAS bf16x8*)(lds + L_CM + (16 * rb + fr) * P128 + (32 * ks + 8 * fq) * 2);
                    const bf16x8 bv = *(const LAS bf16x8*)(lds + L_ST + (16 * cbk + fr) * P128 + (32 * ks + 8 * fq) * 2); acp = mfma16(av, bv, acp); }
                const int p = 16 * cbk + fr;
                const u32x2 xs4 = *(const LAS u32x2*)(lds + L_XST + p * P64 + (16 * rb + 4 * fq) * 2);
                const float xsv[4] = {bflo(xs4.x), bfhi(xs4.x), bflo(xs4.y), bfhi(xs4.y)};
#pragma unroll
                for (int j = 0; j < 4; ++j) { const int l = 16 * rb + 4 * fq + j;
                    LAS bf16_t* zp = (LAS bf16_t*)(lds + L_ZT + l * P64 + p * 2);
                    const float z = bf2f(*zp);
                    const float yg = (acc[j] + el[j] * acp[j] + xsv[j] * dsk) * siluf_(z);
                    *zp = f2bf(yg); sq[j] += yg * yg; } }
#pragma unroll
            for (int j = 0; j < 4; ++j) { const float v = row16_sum(sq[j]);
                if (fr == 0) ssqp[(16 * rb + 4 * fq + j) * 2 + (wave & 1)] = v; }
            const float dec = __builtin_amdgcn_exp2f(acv[63]);
#pragma unroll
            for (int i = 0; i < 4; ++i) { st[i] = st[i] * dec;
#pragma unroll
                for (int ks = 0; ks < 2; ++ks) { const bf16x8 av = *(const LAS bf16x8*)(lds + L_XST + (16 * pb + fr) * P64 + (32 * ks + 8 * fq) * 2);
                    const bf16x8 bv = *(const LAS bf16x8*)(lds + L_BWT + (16 * (nb0 + i) + fr) * P64 + (((4 * ks + fq) ^ ((nb0 + i) & 7)) << 4)); st[i] = mfma16(bv, av, st[i]); } }
        }
        LBAR();
        if (tid < 64) ((LAS float*)(lds + L_SSQA))[c * 64 + tid] = ssqp[tid * 2] + ssqp[tid * 2 + 1];
    }
    LBAR();
    for (int t = tid; t < nchunks * 64; t += 512) ssq[(size_t)(seq_row0 + t) * NH + h] = ((const LAS float*)(lds + L_SSQA))[t];
    { const u32x4 yv = *(const LAS u32x4*)(lds + L_ZT + tok * P64 + oct * 16); *(u32x4*)(const_cast<char*>(pbase) + off_z + (unsigned)(nchunks - 1) * SSD_STEP) = yv; }
#pragma unroll
    for (int i = 0; i < 4; ++i) *(f32x4*)(ssm_out + (16 * pb + fr) * DSTATE + 16 * (nb0 + i) + 4 * fq) = st[i];
}

constexpr int PK = 144, PV = 400;
constexpr int L_KS = 0, L_VT = L_KS + 192 * PK, L_BT = L_VT + 64 * PV, L_ATT_END = L_BT + 4 * 256 * 4;
static_assert(L_ATT_END <= 131072, "attn lds");

__device__ __forceinline__ void attn_item(const Args& a, LAS unsigned char* lds, int layer, bool is_sample, int b, int c, int kvh, int seq_row0, int nchunks, bf16_t* proj, const int tid) {
    const int wave = __builtin_amdgcn_readfirstlane(tid >> 6), lane = tid & 63, fr = lane & 15, fq = lane >> 4;
    const int row0 = seq_row0 + c * 64;
    const float* kng = a.in[21] + layer * 64;
    u32x4 qraw[2][2];
    {
        const int hq_ = kvh * 4 + (wave >> 1);
#pragma unroll
        for (int sub = 0; sub < 2; ++sub) { const bf16_t* qp_ = proj + (size_t)(row0 + (wave & 1) * 32 + sub * 16 + fr) * PN + C_Q + hq_ * 64;
#pragma unroll
            for (int ks = 0; ks < 2; ++ks) qraw[sub][ks] = *(const u32x4*)(qp_ + 32 * ks + 8 * fq); }
    }
#pragma unroll
    for (int i = 0; i < 3; ++i) {
        const int slot = tid + 512 * i, kl = slot >> 3, oc = slot & 7;
        const int pos = c * 64 - 128 + kl;
        float kf[8], vf[8];
        if (is_sample && kl < 128) {
            const size_t off = (((size_t)(layer * NSB + b) * 128 + kl) * NKVH + kvh) * 64 + oc * 8;
            const f32x4 k0 = *(const f32x4*)(a.in[2] + off), k1 = *(const f32x4*)(a.in[2] + off + 4), v0 = *(const f32x4*)(a.in[3] + off), v1 = *(const f32x4*)(a.in[3] + off + 4);
#pragma unroll
            for (int e = 0; e < 4; ++e) { kf[e] = k0[e]; kf[4 + e] = k1[e]; vf[e] = v0[e]; vf[4 + e] = v1[e]; }
        } else if (pos >= 0) {
            const bf16_t* rp = proj + (size_t)(seq_row0 + pos) * PN;
            const u32x4 kw = *(const u32x4*)(rp + C_K + kvh * 64 + oc * 8), vw = *(const u32x4*)(rp + C_V + kvh * 64 + oc * 8);
            kf[0] = bflo(kw.x); kf[1] = bfhi(kw.x); kf[2] = bflo(kw.y); kf[3] = bfhi(kw.y); kf[4] = bflo(kw.z); kf[5] = bfhi(kw.z); kf[6] = bflo(kw.w); kf[7] = bfhi(kw.w);
            vf[0] = bflo(vw.x); vf[1] = bfhi(vw.x); vf[2] = bflo(vw.y); vf[3] = bfhi(vw.y); vf[4] = bflo(vw.z); vf[5] = bfhi(vw.z); vf[6] = bflo(vw.w); vf[7] = bfhi(vw.w);
            float ss = 0.f;
#pragma unroll
            for (int e = 0; e < 8; ++e) ss += kf[e] * kf[e];
            ss += __shfl_xor(ss, 1); ss += __shfl_xor(ss, 2); ss += __shfl_xor(ss, 4);
            const float rs = rsqrtf(ss * (1.f / 64.f) + EPS);
            const f32x4 g0 = *(const f32x4*)(kng + oc * 8), g1 = *(const f32x4*)(kng + oc * 8 + 4);
#pragma unroll
            for (int e = 0; e < 4; ++e) { kf[e] = kf[e] * rs * g0[e]; kf[4 + e] = kf[4 + e] * rs * g1[e]; }
            if (kl >= 128 && (is_sample || c >= nchunks - 2)) {
                const int orow = is_sample ? (kl - 128) : (c - (nchunks - 2)) * 64 + (kl - 128);
                const size_t nb_ = is_sample ? NSB : NPB; const int lr = is_sample ? DSEQ : 128;
                const size_t off = (((size_t)(layer * nb_ + b) * lr + orow) * NKVH + kvh) * 64 + oc * 8;
                float* ko = a.out + (is_sample ? O_KS : O_KP) + off; float* vo = a.out + (is_sample ? O_VS : O_VP) + off;
                *(f32x4*)ko = (f32x4){kf[0], kf[1], kf[2], kf[3]}; *(f32x4*)(ko + 4) = (f32x4){kf[4], kf[5], kf[6], kf[7]};
                *(f32x4*)vo = (f32x4){vf[0], vf[1], vf[2], vf[3]}; *(f32x4*)(vo + 4) = (f32x4){vf[4], vf[5], vf[6], vf[7]};
            }
        } else {
#pragma unroll
            for (int e = 0; e < 8; ++e) { kf[e] = 0.f; vf[e] = 0.f; }
        }
        u32x4 w; w.x = pk2(kf[0], kf[1]); w.y = pk2(kf[2], kf[3]); w.z = pk2(kf[4], kf[5]); w.w = pk2(kf[6], kf[7]);
        *(LAS u32x4*)(lds + L_KS + kl * PK + oc * 16) = w;
#pragma unroll
        for (int e = 0; e < 8; ++e) *(LAS bf16_t*)(lds + L_VT + (oc * 8 + e) * PV + (kl ^ (oc << 2)) * 2) = f2bf(vf[e]);
    }
    LAS float* bt = (LAS float*)(lds + L_BT);
    for (int idx = tid; idx < 1024; idx += 512) { const int g = idx >> 8, ri = idx & 255; const int rel = ri - 191;
        int n = -rel; int ret = n < 0 ? 16 : 0; n = n < 0 ? -n : n;
        int bk;
        if (n < 8) bk = n; else if (n < 12) bk = 8; else if (n < 16) bk = 9; else if (n < 23) bk = 10; else if (n < 32) bk = 11; else if (n < 46) bk = 12; else if (n < 64) bk = 13; else if (n < 91) bk = 14; else bk = 15;
        bt[idx] = a.in[8][(ret + bk) * NQH + kvh * 4 + g]; }
    __syncthreads();
    const int g = wave >> 1, hq = kvh * 4 + g;
    const float sink = a.in[22][layer * NQH + hq];
    const float* qng = a.in[20] + layer * 64;
    const int kmin = is_sample ? 0 : (2 - c) * 64;
#pragma unroll 1
    for (int sub = 0; sub < 2; ++sub) {
        const int ql = (wave & 1) * 32 + sub * 16 + fr;
        bf16_t* qp = proj + (size_t)(row0 + ql) * PN + C_Q + hq * 64;
        bf16x8 qf[2];
        {
            float qv[2][8]; float ss = 0.f;
#pragma unroll
            for (int ks = 0; ks < 2; ++ks) { const u32x4 w = sub ? qraw[1][ks] : qraw[0][ks];
                qv[ks][0] = bflo(w.x); qv[ks][1] = bfhi(w.x); qv[ks][2] = bflo(w.y); qv[ks][3] = bfhi(w.y); qv[ks][4] = bflo(w.z); qv[ks][5] = bfhi(w.z); qv[ks][6] = bflo(w.w); qv[ks][7] = bfhi(w.w);
#pragma unroll
                for (int e = 0; e < 8; ++e) ss += qv[ks][e] * qv[ks][e]; }
            ss += __shfl_xor(ss, 16); ss += __shfl_xor(ss, 32);
            const float rs = rsqrtf(ss * (1.f / 64.f) + EPS) * 0.125f;
#pragma unroll
            for (int ks = 0; ks < 2; ++ks) { const f32x4 g0 = *(const f32x4*)(qng + 32 * ks + 8 * fq), g1 = *(const f32x4*)(qng + 32 * ks + 8 * fq + 4);
                u32x4 w; w.x = pk2(qv[ks][0] * rs * g0[0], qv[ks][1] * rs * g0[1]); w.y = pk2(qv[ks][2] * rs * g0[2], qv[ks][3] * rs * g0[3]);
                w.z = pk2(qv[ks][4] * rs * g1[0], qv[ks][5] * rs * g1[1]); w.w = pk2(qv[ks][6] * rs * g1[2], qv[ks][7] * rs * g1[3]);
                qf[ks] = __builtin_bit_cast(bf16x8, w); }
        }
        f32x4 sacc[12];
#pragma unroll
        for (int kb = 0; kb < 12; ++kb) { sacc[kb] = (f32x4){0.f, 0.f, 0.f, 0.f};
#pragma unroll
            for (int ks = 0; ks < 2; ++ks) { const bf16x8 av = *(const LAS bf16x8*)(lds + L_KS + (16 * kb + fr) * PK + (32 * ks + 8 * fq) * 2); sacc[kb] = mfma16(av, qf[ks], sacc[kb]); } }
        float mx = sink;
#pragma unroll
        for (int kb = 0; kb < 12; ++kb)
#pragma unroll
            for (int j = 0; j < 4; ++j) { const int kl = 16 * kb + 4 * fq + j;
                const float s = sacc[kb][j] + bt[g * 256 + kl - 128 - ql + 191];
                sacc[kb][j] = s; mx = fmaxf(mx, s); }
        if (kmin > 0) {
            mx = sink;
#pragma unroll
            for (int kb = 0; kb < 12; ++kb)
#pragma unroll
                for (int j = 0; j < 4; ++j) { const int kl = 16 * kb + 4 * fq + j; if (kl < kmin) sacc[kb][j] = -INFINITY; mx = fmaxf(mx, sacc[kb][j]); }
        }
        mx = fmaxf(mx, __shfl_xor(mx, 16)); mx = fmaxf(mx, __shfl_xor(mx, 32));
        float sum = 0.f;
#pragma unroll
        for (int kb = 0; kb < 12; ++kb)
#pragma unroll
            for (int j = 0; j < 4; ++j) { const float p = __expf(sacc[kb][j] - mx); sacc[kb][j] = p; sum += p; }
        sum += __shfl_xor(sum, 16); sum += __shfl_xor(sum, 32);
        const float inv = __builtin_amdgcn_rcpf(sum + __expf(sink - mx));
        f32x4 oacc[4];
#pragma unroll
        for (int db = 0; db < 4; ++db) oacc[db] = (f32x4){0.f, 0.f, 0.f, 0.f};
#pragma unroll
        for (int ks = 0; ks < 6; ++ks) {
            u32x4 pw; pw.x = pk2(sacc[2 * ks][0], sacc[2 * ks][1]); pw.y = pk2(sacc[2 * ks][2], sacc[2 * ks][3]); pw.z = pk2(sacc[2 * ks + 1][0], sacc[2 * ks + 1][1]); pw.w = pk2(sacc[2 * ks + 1][2], sacc[2 * ks + 1][3]);
            const bf16x8 pbv = __builtin_bit_cast(bf16x8, pw);
#pragma unroll
            for (int db = 0; db < 4; ++db) { const LAS unsigned char* vr = lds + L_VT + (16 * db + fr) * PV; const int vkey = ((2 * db + (fr >> 3)) & 7) << 2;
                const u32x2 lo = *(const LAS u32x2*)(vr + ((32 * ks + 4 * fq) ^ vkey) * 2), hi = *(const LAS u32x2*)(vr + ((32 * ks + 16 + 4 * fq) ^ vkey) * 2);
                u32x4 vw; vw.x = lo.x; vw.y = lo.y; vw.z = hi.x; vw.w = hi.y;
                oacc[db] = mfma16(__builtin_bit_cast(bf16x8, vw), pbv, oacc[db]); }
        }
#pragma unroll
        for (int db = 0; db < 4; ++db) { u32x2 w; w.x = pk2(oacc[db][0] * inv, oacc[db][1] * inv); w.y = pk2(oacc[db][2] * inv, oacc[db][3] * inv);
            *(u32x2*)(qp + 16 * db + 4 * fq) = w; }
    }
    __syncthreads();
}

#define XB_TMO      128
#define XB_XCNT(j)  (256  + 64 * (j))
#define XB_XSUB(j)  (1280 + 64 * (j))
#define XB_XGEN(j)  (2304 + 64 * (j))
#define XB_TOP      3328
#define XB_TOPGEN   3392
#define XCD_BAR_WORDS 3456
#define XB_SPIN_CAP (1u << 22)
__device__ __forceinline__ unsigned xb_ld(unsigned* p)              { return __hip_atomic_load(p, __ATOMIC_RELAXED, __HIP_MEMORY_SCOPE_AGENT); }
__device__ __forceinline__ unsigned xb_add(unsigned* p, unsigned v) { return __hip_atomic_fetch_add(p, v, __ATOMIC_RELAXED, __HIP_MEMORY_SCOPE_AGENT); }
__device__ __forceinline__ unsigned xb_xcc_id() { return (unsigned)__builtin_amdgcn_s_getreg((3 << 11) | 20) & 0xFu; }
#define XB_SPIN(cond, bar) do { unsigned _sp = 0; while (cond) { __builtin_amdgcn_s_sleep(1); \
    if ((++_sp & 255u) == 0u) { if (xb_ld(&(bar)[XB_TMO])) break; if (_sp > XB_SPIN_CAP) { atomicAdd(&(bar)[XB_TMO], 1u); break; } } } } while (0)
struct XcdBarrier { unsigned* bar; unsigned x; volatile LAS unsigned* st; };
__device__ __forceinline__ XcdBarrier xcd_barrier_post(unsigned* bar, volatile LAS unsigned* st) {
    XcdBarrier b; b.bar = bar; b.x = xb_xcc_id(); b.st = st;
    if (threadIdx.x == 0) (void)xb_add(&bar[XB_XCNT(b.x)], 1u);
    return b;
}
__device__ __forceinline__ void xcd_barrier_complete(unsigned* bar, unsigned x, unsigned& nloc, unsigned& nx) {
    const unsigned G = gridDim.x * gridDim.y * gridDim.z;
    unsigned sum, cnt, mine, sp = 0u;
    for (;;) {
        sum = 0u; cnt = 0u; mine = 0u;
#pragma unroll
        for (unsigned j = 0; j < 16; ++j) { const unsigned c = xb_ld(&bar[XB_XCNT(j)]); sum += c; cnt += (c > 0u) ? 1u : 0u; mine = (j == x) ? c : mine; }
        if (sum == G) break;
        __builtin_amdgcn_s_sleep(1);
        if ((++sp & 255u) == 0u) { if (xb_ld(&bar[XB_TMO])) break; if (sp > XB_SPIN_CAP) { atomicAdd(&bar[XB_TMO], 1u); break; } }
    }
    nloc = mine > 0u ? mine : 1u; nx = cnt > 0u ? cnt : 1u;
}
__device__ __forceinline__ void xcd_barrier(const XcdBarrier& b) {
    asm volatile("s_waitcnt vmcnt(0)" ::: "memory");
    __syncthreads();
    if (threadIdx.x == 0) {
        unsigned* bar = b.bar;
        __builtin_amdgcn_s_waitcnt(0);
        unsigned nloc = b.st[0], nx = b.st[1];
        if (nloc == 0u) { xcd_barrier_complete(bar, b.x, nloc, nx); b.st[0] = nloc; b.st[1] = nx; }
        const unsigned old = xb_add(&bar[XB_XSUB(b.x)], 1u);
        const unsigned gen = old / nloc;
        if (old + 1u == (gen + 1u) * nloc) {
            __builtin_amdgcn_fence(__ATOMIC_RELEASE, "agent");
            asm volatile("s_waitcnt vmcnt(0)" ::: "memory");
            const unsigned og = xb_add(&bar[XB_TOP], 1u);
            const unsigned tg = og / nx;
            if (og + 1u == (tg + 1u) * nx) xb_add(&bar[XB_TOPGEN], 1u);
            else XB_SPIN(xb_ld(&bar[XB_TOPGEN]) == tg, bar);
            __builtin_amdgcn_fence(__ATOMIC_ACQUIRE, "agent");
            xb_add(&bar[XB_XGEN(b.x)], 1u);
            asm volatile("s_waitcnt vmcnt(0)" ::: "memory");
        } else {
            XB_SPIN(xb_ld(&bar[XB_XGEN(b.x)]) == gen, bar);
            __builtin_amdgcn_fence(__ATOMIC_ACQUIRE, "agent");
            asm volatile("s_waitcnt vmcnt(0)" ::: "memory");
        }
    }
    __syncthreads();
}

#define OPAQUE_TID() int tq = threadIdx.x; asm volatile("" : "+v"(tq))
__global__ void __launch_bounds__(512, 2) mega_fwd(Args a) {
    extern __shared__ __attribute__((aligned(16))) unsigned char lds_raw[];
    LAS unsigned char* lds = (LAS unsigned char*)lds_raw;
    cg::grid_group grid = cg::this_grid();
    const int tid = threadIdx.x, lane = tid & 63, wave = __builtin_amdgcn_readfirstlane(tid >> 6);
    const int G = gridDim.x, bx = blockIdx.x, gw = bx * 8 + wave, NGW = G * 8;
    bf16_t* Hb = (bf16_t*)(a.ws + WS_H); bf16_t* proj = (bf16_t*)(a.ws + WS_PROJ); float* ssq = (float*)(a.ws + WS_SSQ);
    const float* modall = (const float*)(a.ws + WS_MOD);

    for (int w = bx * 512 + tid; w < XCD_BAR_WORDS; w += G * 512) __hip_atomic_store((unsigned*)(a.ws + WS_CTL) + w, 0u, __ATOMIC_RELAXED, __HIP_MEMORY_SCOPE_AGENT);
    prologue_weights(a, lds, gw, NGW, wave, lane);
    for (int it = bx; it < 192; it += G) prologue_mod_item(a, lds, it, tid);
    volatile LAS unsigned* bst = (volatile LAS unsigned*)(lds + LDS_BYTES - 64);
    if (tid < 2) bst[tid] = 0u;
    __syncthreads();
    grid.sync();
    XcdBarrier xbar = xcd_barrier_post((unsigned*)(a.ws + WS_CTL), bst);

#pragma unroll 1
    for (int layer = 0; layer < 2; ++layer) {
#pragma unroll 1
        for (int slab = 0; slab < 2; ++slab) {
            const int row_base = slab * SLAB0_ROWS, nrows = slab == 0 ? SLAB0_ROWS : SLAB1_ROWS, nMt = nrows / 256;
            const unsigned char* wl = a.ws + (size_t)layer * W_LAYER;
            const float* mod = modall + (size_t)layer * NSEQ * (6 * DM);
            const float* xin_p = layer == 0 ? a.in[0] : a.out + O_Y;
            const float* xin_s = layer == 0 ? a.in[1] : a.out + O_Y + (size_t)MP * DM;
            { OPAQUE_TID(); norm_mod_rows(xin_p, xin_s, a.in[11] + layer * DM, mod, 0, 1, Hb, row_base, nrows, gw, NGW, tq & 63); }
            xcd_barrier(xbar);
            { pg8::Gemm g; g.A0 = g.A1 = g.A2 = Hb; g.B0 = g.B1 = g.B2 = (const bf16_t*)(wl + W_IN); g.K0 = g.K1 = g.K2 = DM; g.lda = DM; g.ldb = DM;
              pg8::StaticOrder S; S.init(nMt, PN / 256, G, bx, 1); EpiProj E{proj, PN};
              OPAQUE_TID(); pg8::gemm_phase<EpiProj>(lds, g, S, E, tq); }
            xcd_barrier(xbar);
            {
                const int nCp = 8 * 32, nCs = slab == 0 ? 0 : NSB * 8;
                for (int L = bx; L < nCp + nCs; L += G) {
                    OPAQUE_TID();
                    if (L < nCp) { const int b = slab * 8 + (L >> 5); convbc_item(a, layer, false, b, L & 31, b * SEQ - row_base, proj, tq); }
                    else { const int r = L - nCp, b = r >> 3; convbc_item(a, layer, true, b, r & 7, MP + b * DSEQ - row_base, proj, tq); }
                }
            }
            xcd_barrier(xbar);
            {
                const int npseq = 8, nsseq = slab == 0 ? 0 : NSB;
                OPAQUE_TID();
                for (int idx = bx * 512 + tq; idx < (npseq + nsseq) * 3 * DIN; idx += G * 512) {
                    const int sq = idx / (3 * DIN), rem = idx - sq * (3 * DIN), r = rem / DIN, chn = rem - r * DIN;
                    if (sq < npseq) { const int b = slab * 8 + sq; const int lrow = b * SEQ - row_base + (SEQ - 3 + r);
                        a.out[O_CONVP + ((size_t)(layer * NPB + b) * 3 + r) * CONVC + chn] = bf2f(proj[(size_t)lrow * PN + C_XBC + chn]); }
                    else { const int b = sq - npseq; const int lrow = MP + b * DSEQ - row_base + (DSEQ - 3 + r);
                        a.out[O_CONVS + ((size_t)(layer * NSB + b) * 3 + r) * CONVC + chn] = bf2f(proj[(size_t)lrow * PN + C_XBC + chn]); }
                }
                const int nP = 8 * NH, nS = slab == 0 ? 0 : NSB * NH, nAp = 8 * 32 * NKVH, nAs = slab == 0 ? 0 : NSB * NKVH;
                const int total = nP + nS + nAp + nAs;
                for (int L = bx; L < total; L += G) {
                    int r = L;
                    if (r < nP) { const int b = slab * 8 + r / NH, h = r % NH; OPAQUE_TID(); ssd_item(a, lds, layer, false, b, h, b * SEQ - row_base, 32, proj, ssq, tq); continue; } r -= nP;
                    if (r < nS) { const int b = r / NH, h = r % NH; OPAQUE_TID(); ssd_item(a, lds, layer, true, b, h, MP + b * DSEQ - row_base, 1, proj, ssq, tq); continue; } r -= nS;
                    if (r < nAp) { const int kvh = r & 3, c = (r >> 2) & 31, b = slab * 8 + (r >> 7); OPAQUE_TID(); attn_item(a, lds, layer, false, b, c, kvh, b * SEQ - row_base, 32, proj, tq); continue; } r -= nAp;
                    { const int kvh = r & 3, b = r >> 2; OPAQUE_TID(); attn_item(a, lds, layer, true, b, 0, kvh, MP + b * DSEQ - row_base, 1, proj, tq); }
                }
            }
            xcd_barrier(xbar);
            { pg8::Gemm g; g.A0 = proj + C_Z; g.A1 = g.A2 = proj + C_Q; g.B0 = (const bf16_t*)(wl + W_BR); g.B1 = g.B2 = (const bf16_t*)(wl + W_BR) + 2048; g.K0 = DIN; g.K1 = g.K2 = DM; g.lda = PN; g.ldb = 3072;
              pg8::StaticOrder S; S.init(nMt, 4, G, bx, 2); EpiBr E{proj, Hb};
              OPAQUE_TID();
              {
                  Unit u; const int k = tq >> 8, row = tq & 255;
                  if (S.next(2 * k, u)) {
                      const f32x4* q = (const f32x4*)(ssq + (size_t)(u.pm * 256 + row) * NH);
                      float r[4];
#pragma unroll
                      for (int gq = 0; gq < 4; ++gq) { const f32x4 x0 = q[2 * gq], x1 = q[2 * gq + 1]; r[gq] = rsqrtf(((x0[0] + x0[1]) + (x0[2] + x0[3]) + (x1[0] + x1[1]) + (x1[2] + x1[3])) * (1.f / 512.f) + EPS); }
                      *(LAS f32x4*)(lds + pg8::STAGE_BYTES + (k * 256 + row) * 16) = (f32x4){r[0] / r[1], r[1] / r[2], r[2] / r[3], r[3]};
                  }
                  __syncthreads();
              }
              pg8::gemm_phase<EpiBr, true>(lds, g, S, E, tq); }
            xcd_barrier(xbar);
            { pg8::Gemm g; g.A0 = g.A1 = g.A2 = Hb; g.B0 = g.B1 = g.B2 = (const bf16_t*)(wl + W_O); g.K0 = g.K1 = g.K2 = DM; g.lda = DM; g.ldb = DM;
              pg8::StaticOrder S; S.init(nMt, 4, G, bx, 1); EpiRes E{xin_p, xin_s, a.out + O_Y, mod + 2 * DM, row_base};
              OPAQUE_TID(); pg8::gemm_phase<EpiRes>(lds, g, S, E, tq); }
            xcd_barrier(xbar);
        }
        {
            const unsigned char* wl = a.ws + (size_t)layer * W_LAYER;
            const float* mod = modall + (size_t)layer * NSEQ * (6 * DM);
            { OPAQUE_TID(); norm_mod_rows(a.out + O_Y, a.out + O_Y + (size_t)MP * DM, a.in[12] + layer * DM, mod, 3, 4, Hb, 0, MTOT, gw, NGW, tq & 63); }
            xcd_barrier(xbar);
            { pg8::Gemm g; g.A0 = g.A1 = g.A2 = Hb; g.B0 = g.B1 = g.B2 = (const bf16_t*)(wl + W_GU); g.K0 = g.K1 = g.K2 = DM; g.lda = DM; g.ldb = DM;
              pg8::StaticOrder S; S.init(MTOT / 256, 2 * DFF / 256, G, bx, 1); EpiSwiglu E{proj};
              OPAQUE_TID(); pg8::gemm_phase<EpiSwiglu>(lds, g, S, E, tq); }
            xcd_barrier(xbar);
            { pg8::Gemm g; g.A0 = g.A1 = proj; g.A2 = proj + DFF / 2; g.B0 = g.B1 = (const bf16_t*)(wl + W_D); g.B2 = (const bf16_t*)(wl + W_D) + DFF / 2; g.K0 = DFF; g.K1 = g.K2 = DFF / 2; g.lda = DFF; g.ldb = DFF;
              pg8::StaticOrder S; S.init(MTOT / 256, 4, G, bx, 1, false);    EpiRes E{a.out + O_Y, a.out + O_Y + (size_t)MP * DM, a.out + O_Y, mod + 5 * DM, 0};
              OPAQUE_TID(); pg8::gemm_phase<EpiRes>(lds, g, S, E, tq); }
            if (layer == 0) xcd_barrier(xbar);
        }
    }
}

extern "C" void kernel_launch(void* const* d_in, const int* in_sizes, int n_in, void* d_out, int out_size, void* d_ws, size_t ws_size, hipStream_t stream) {
    static int grid = 0;
    if (grid == 0) {
        if (n_in != 28 || ws_size < WS_END) { fprintf(stderr, "kernel_launch: need 28 inputs and %zu bytes of workspace (got %d, %zu)\n", (size_t)WS_END, n_in, ws_size); grid = -1; return; }
        int dev = 0, cus = 0, per_cu = 0;
        hipGetDevice(&dev);
        hipDeviceGetAttribute(&cus, hipDeviceAttributeMultiprocessorCount, dev);
        hipFuncSetAttribute((const void*)mega_fwd, hipFuncAttributeMaxDynamicSharedMemorySize, LDS_BYTES);
        hipOccupancyMaxActiveBlocksPerMultiprocessor(&per_cu, (const void*)mega_fwd, 512, LDS_BYTES);
        if (per_cu < 1) per_cu = 1;
        grid = cus;
        (void)hipGetLastError();
    }
    if (grid < 0) return;
    Args a{};
    for (int i = 0; i < 28; ++i) a.in[i] = (const float*)d_in[i];
    a.out = (float*)d_out; a.ws = (unsigned char*)d_ws;
    void* args[] = {&a};
    hipError_t e = hipLaunchCooperativeKernel((const void*)mega_fwd, dim3(grid), dim3(512), args, LDS_BYTES, stream);
    if (e != hipSuccess) fprintf(stderr, "cooperative launch failed: %s (grid %d)\n", hipGetErrorString(e), grid);
}
```

```cpp
#include <hip/hip_runtime.h>
#include <hip/hip_cooperative_groups.h>
#include <cstdio>
#include <cstdint>
namespace cg = cooperative_groups;

#define LAS __attribute__((address_space(3)))
typedef unsigned short bf16_t;
typedef short bf16x8 __attribute__((ext_vector_type(8)));
typedef short s16x4 __attribute__((ext_vector_type(4)));
typedef float f32x4 __attribute__((ext_vector_type(4)));
typedef unsigned u32x4 __attribute__((ext_vector_type(4)));
typedef unsigned u32x2 __attribute__((ext_vector_type(2)));
typedef float f32x2 __attribute__((ext_vector_type(2)));

constexpr int DM = 1024, NPB = 16, SEQ = 2048, NSB = 32, DSEQ = 64, MP = NPB * SEQ, MS = NSB * DSEQ, MTOT = MP + MS;
constexpr int DIN = 2048, CONVC = 3072, NH = 32, DSTATE = 128, NQH = 16, NKVH = 4, DFF = 2816, INCOLS = 8736;
constexpr int PN = 8960;
constexpr int C_Z = 0, C_XBC = 2048, C_Q = 5120, C_K = 6144, C_V = 6400, C_GS = 6656, C_GA = 7680, C_DT = 8704;
constexpr int NSEQ = NPB + NSB;
constexpr float EPS = 1e-6f;
constexpr int SLAB0_ROWS = 16384, SLAB1_ROWS = MTOT - SLAB0_ROWS;
constexpr int SLAB_MAXROWS = SLAB1_ROWS;

constexpr size_t O_Y = 0, O_CONVP = 35651584, O_CONVS = 35946496, O_SSMP = 36536320, O_SSMS = 44924928,
                 O_KP = 61702144, O_KS = 62750720, O_VP = 63799296, O_VS = 64847872;

constexpr size_t W_IN = 0, W_BR = 18350080, W_O = 24641536, W_GU = 26738688, W_D = 38273024, W_LAYER = 44040192;
constexpr size_t WS_MOD = 2 * W_LAYER, WS_SSQ = WS_MOD + 2359296, WS_H = WS_SSQ + 2359296, WS_PROJ = WS_H + (size_t)MTOT * DM * 2,
                 WS_CTL = WS_PROJ + (size_t)SLAB_MAXROWS * PN * 2, WS_END = WS_CTL + 16384;

constexpr int LDS_BYTES = 140 * 1024;

__device__ __forceinline__ unsigned pk2(float lo, float hi) { unsigned r; asm("v_cvt_pk_bf16_f32 %0, %1, %2" : "=v"(r) : "v"(lo), "v"(hi)); return r; }
__device__ __forceinline__ bf16_t f2bf(float f) { return (bf16_t)(pk2(f, 0.f) & 0xffffu); }
__device__ __forceinline__ float bflo(unsigned w) { return __uint_as_float(w << 16); }
__device__ __forceinline__ float bfhi(unsigned w) { return __uint_as_float(w & 0xffff0000u); }
__device__ __forceinline__ float bf2f(bf16_t h) { return __uint_as_float(((unsigned)h) << 16); }
__device__ __forceinline__ float sigmoidf_(float x) { return __builtin_amdgcn_rcpf(1.f + __expf(-x)); }
__device__ __forceinline__ float siluf_(float x) { return x * __builtin_amdgcn_rcpf(1.f + __expf(-x)); }
__device__ __forceinline__ float row16_sum(float v) {
    v += __builtin_bit_cast(float, __builtin_amdgcn_update_dpp(0, __builtin_bit_cast(int, v), 0xB1, 0xF, 0xF, true));
    v += __builtin_bit_cast(float, __builtin_amdgcn_update_dpp(0, __builtin_bit_cast(int, v), 0x4E, 0xF, 0xF, true));
    v += __builtin_bit_cast(float, __builtin_amdgcn_update_dpp(0, __builtin_bit_cast(int, v), 0x141, 0xF, 0xF, true));
    v += __builtin_bit_cast(float, __builtin_amdgcn_update_dpp(0, __builtin_bit_cast(int, v), 0x140, 0xF, 0xF, true));
    return v;
}
__device__ __forceinline__ f32x4 mfma16(bf16x8 a, bf16x8 b, f32x4 c) { return __builtin_amdgcn_mfma_f32_16x16x32_bf16(a, b, c, 0, 0, 0); }
#define LDS_WAIT() asm volatile("s_waitcnt lgkmcnt(0)" ::: "memory")
#define LBAR() do { asm volatile("s_waitcnt lgkmcnt(0)" ::: "memory"); __builtin_amdgcn_s_barrier(); asm volatile("" ::: "memory"); } while (0)

namespace pg8 {
constexpr int BM = 256, BK = 64, HALF = 128, HTB = HALF * BK * 2, STAGE_BYTES = 8 * HTB, NXCD = 8, WGM = 8;
__host__ __device__ __forceinline__ int lds_byte(int r, int c) { const int st = (r >> 4) * 2 + (c >> 5), rr = r & 15, cc = c & 31, ob = rr * 64 + cc * 2; return st * 1024 + (ob ^ (((ob >> 9) & 1) << 5)); }
__host__ __device__ __forceinline__ void stage_rc(int b, int& R, int& C) { const int st = b / 1024, sb = b % 1024, swz = sb ^ (((sb >> 9) & 1) << 5); R = (st >> 1) * 16 + swz / 64; C = (st & 1) * 32 + (swz % 64) / 2; }
__host__ __device__ __forceinline__ int perm32(int rho) { const int n = rho >> 4, i = rho & 15; return 8 * (i >> 2) + 4 * n + (i & 3); }

struct Unit { int pm, pn, part; };
struct Gemm { const bf16_t* A0; const bf16_t* A1; const bf16_t* A2; const bf16_t* B0; const bf16_t* B1; const bf16_t* B2; int K0, K1, K2; int lda, ldb;
    __device__ __forceinline__ const char* Ap(int part) const { return (const char*)A0 + (long)(part == 1) * ((const char*)A1 - (const char*)A0) + (long)(part == 2) * ((const char*)A2 - (const char*)A0); }
    __device__ __forceinline__ const char* Bp(int part) const { return (const char*)B0 + (long)(part == 1) * ((const char*)B1 - (const char*)B0) + (long)(part == 2) * ((const char*)B2 - (const char*)B0); }
    __device__ __forceinline__ int Kp(int part) const { return K0 + (part == 1) * (K1 - K0) + (part == 2) * (K2 - K0); } };

struct StaticOrder {
    int nM, nN, nwg, G, c, np, split_from;
    __device__ __forceinline__ void init(int nM_, int nN_, int G_, int c_, int np_, bool split_tail = false) { nM = nM_; nN = nN_; nwg = nM * nN; G = G_; c = c_; np = np_; split_from = split_tail ? (nwg / G) * G : nwg; }
    __device__ __forceinline__ bool next(int i, Unit& u) const {
        const int r = i / np; u.part = i - r * np;
        long L = (long)r * G + c;
        if (L >= split_from) { const long Ls = L - split_from; if (Ls >= 2L * (nwg - split_from)) return false; L = split_from + (Ls >> 1); u.part = 1 + (int)(Ls & 1); }
        if (L >= nwg) return false;
        int wgid = (int)L; { const int q = nwg / NXCD, rr = nwg % NXCD, xcd = wgid % NXCD, off = wgid / NXCD; wgid = (xcd < rr ? xcd * (q + 1) : rr * (q + 1) + (xcd - rr) * q) + off; }
        const int nig = WGM * nN, gid = wgid / nig, fm = gid * WGM, gsz = (nM - fm) < WGM ? (nM - fm) : WGM;
        u.pm = fm + ((wgid % nig) % gsz); u.pn = (wgid % nig) / gsz; return true;
    }
};

template <class Epi, bool GS = false>
__device__ __forceinline__ void gemm_phase(LAS unsigned char* lds, const Gemm g, const StaticOrder& S, const Epi& E, const int tid) {
    const int wid = __builtin_amdgcn_readfirstlane(tid >> 6), lane = tid & 63, wr = wid >> 2, wc = wid & 3, fr = lane & 15, fq = lane >> 4;
    unsigned voffA[2], voffB[2];
#pragma unroll
    for (int i = 0; i < 2; ++i) { int R, C; stage_rc(tid * 16 + i * 8192, R, C); const int Rb = Epi::PERM ? ((R & ~31) + perm32(R & 31)) : R;
        voffA[i] = (unsigned)(R * g.lda + C) * 2u; voffB[i] = (unsigned)(Rb * g.ldb + C) * 2u; }
    const size_t kstep = (size_t)(BK * 2);
    const size_t hstepA = (size_t)HALF * g.lda * 2, hstepB = (size_t)HALF * g.ldb * 2;
    const size_t tstepA = 2 * hstepA, tstepB = 2 * hstepB;
    const unsigned ldsw = (unsigned)wid * 1024u;
    const int aoff = lds_byte(wr * 64 + fr, fq * 8), boff = lds_byte(wc * 32 + fr, fq * 8);
#define PG8_SA(b, h) (((b) * 2 + (h)) * HTB)
#define PG8_SB(b, h) ((4 + (b) * 2 + (h)) * HTB)
#define PG8_STAGE(bufoff, gbase, voff) do { _Pragma("unroll") for (int _i = 0; _i < 2; ++_i) \
        __builtin_amdgcn_global_load_lds((const unsigned*)((const char*)(gbase) + (voff)[_i]), (LAS unsigned*)(lds + (bufoff) + ldsw + _i * 8192), 16, 0, 0); } while (0)
#define PG8_LDA(dst, b, h) do { _Pragma("unroll") for (int m = 0; m < 4; ++m) _Pragma("unroll") for (int k = 0; k < 2; ++k) dst[m][k] = *(const LAS bf16x8*)(lds + PG8_SA(b, h) + aoff + m * 2048 + k * 1024); } while (0)
#define PG8_LDB(dst, b, h) do { _Pragma("unroll") for (int n = 0; n < 2; ++n) _Pragma("unroll") for (int k = 0; k < 2; ++k) dst[n][k] = *(const LAS bf16x8*)(lds + PG8_SB(b, h) + boff + n * 2048 + k * 1024); } while (0)
#define PG8_MMA(ai, bj, At, Bt) do { __builtin_amdgcn_s_setprio(1); _Pragma("unroll") for (int m = 0; m < 4; ++m) _Pragma("unroll") for (int n = 0; n < 2; ++n) _Pragma("unroll") for (int k = 0; k < 2; ++k) \
        acc[ai][bj][m][n] = __builtin_amdgcn_mfma_f32_16x16x32_bf16(Bt[n][k], At[m][k], acc[ai][bj][m][n], 0, 0, 0); __builtin_amdgcn_s_setprio(0); } while (0)
#define PG8_WAIT_V(n) asm volatile("s_waitcnt vmcnt(" #n ")" ::: "memory")
#define PG8_WAIT_L(n) asm volatile("s_waitcnt lgkmcnt(" #n ")" ::: "memory")
#define PG8_BAR __builtin_amdgcn_s_barrier()
#define PG8_SCHED __builtin_amdgcn_sched_barrier(0)
    Unit cur, nxt; int ui = 0;
    if (!S.next(0, cur)) return;
    f32x4 acc[2][2][4][2];
#pragma unroll
    for (int a = 0; a < 2; ++a)
#pragma unroll
        for (int b = 0; b < 2; ++b)
#pragma unroll
            for (int m = 0; m < 4; ++m)
#pragma unroll
                for (int n = 0; n < 2; ++n) acc[a][b][m][n] = (f32x4){0.f, 0.f, 0.f, 0.f};
    bf16x8 At[4][2], B0[2][2], B1[2][2];
    const char* cA = g.Ap(cur.part) + (size_t)cur.pm * tstepA; const char* cB = g.Bp(cur.part) + (size_t)cur.pn * tstepB;
    PG8_STAGE(PG8_SB(0, 0), cB, voffB); PG8_STAGE(PG8_SB(0, 1), cB + hstepB, voffB); PG8_STAGE(PG8_SA(0, 0), cA, voffA); PG8_STAGE(PG8_SA(0, 1), cA + hstepA, voffA);
    if (wr == 1) PG8_BAR;
    PG8_WAIT_V(2); PG8_BAR;
    PG8_STAGE(PG8_SB(1, 0), cB + kstep, voffB); PG8_STAGE(PG8_SA(1, 0), cA + kstep, voffA); PG8_STAGE(PG8_SB(1, 1), cB + hstepB + kstep, voffB);
    PG8_WAIT_V(6); PG8_BAR;
    for (;;) {
        const bool has_next = S.next(ui + 1, nxt);
        const char* nA = has_next ? g.Ap(nxt.part) + (size_t)nxt.pm * tstepA : cA; const char* nB = has_next ? g.Bp(nxt.part) + (size_t)nxt.pn * tstepB : cB;
        const int nt = g.Kp(cur.part) / BK;
        const int seg = (GS && cur.part == 0) ? 8 : nt;
        for (int tg = 0; tg < nt; tg += seg) {
        for (int t = tg; t < tg + seg; t += 2) {
            const bool last = (t == nt - 2);
            const char* a1 = cA + (size_t)(t + 1) * kstep;
            const char* a2 = last ? nA : cA + (size_t)(t + 2) * kstep; const char* b2 = last ? nB : cB + (size_t)(t + 2) * kstep;
            const char* a3 = a2 + kstep; const char* b3 = b2 + kstep;
            PG8_LDB(B0, 0, 0); PG8_LDB(B1, 0, 1); PG8_SCHED; PG8_LDA(At, 0, 0); PG8_STAGE(PG8_SA(1, 1), a1 + hstepA, voffA);
            PG8_WAIT_V(8); PG8_WAIT_L(0); PG8_BAR; PG8_MMA(0, 0, At, B0); PG8_MMA(0, 1, At, B1); PG8_BAR; PG8_SCHED;
            PG8_LDA(At, 0, 1); PG8_STAGE(PG8_SB(0, 0), b2, voffB); PG8_STAGE(PG8_SB(0, 1), b2 + hstepB, voffB); PG8_STAGE(PG8_SA(0, 0), a2, voffA);
            PG8_WAIT_V(8); PG8_WAIT_L(0); PG8_BAR; PG8_MMA(1, 0, At, B0); PG8_MMA(1, 1, At, B1); PG8_BAR; PG8_SCHED;
            PG8_LDB(B0, 1, 0); PG8_LDB(B1, 1, 1); PG8_SCHED; PG8_LDA(At, 1, 0); PG8_STAGE(PG8_SA(0, 1), a2 + hstepA, voffA);
            PG8_WAIT_V(8); PG8_WAIT_L(0); PG8_BAR; PG8_MMA(0, 0, At, B0); PG8_MMA(0, 1, At, B1); PG8_BAR; PG8_SCHED;
            PG8_LDA(At, 1, 1); PG8_STAGE(PG8_SB(1, 0), b3, voffB); PG8_STAGE(PG8_SB(1, 1), b3 + hstepB, voffB); PG8_STAGE(PG8_SA(1, 0), a3, voffA);
            PG8_WAIT_V(8); PG8_WAIT_L(0); PG8_BAR; PG8_MMA(1, 0, At, B0); PG8_MMA(1, 1, At, B1); PG8_BAR; PG8_SCHED;
        }
        if constexpr (GS) {
            const bool ds = cur.part == 0;
            const LAS float* rt = (const LAS float*)(lds + STAGE_BYTES) + (ui >> 1) * 1024 + (tg >> 3) + (wr * 64 + fr) * 4;
#pragma unroll
            for (int a = 0; a < 2; ++a)
#pragma unroll
                for (int m = 0; m < 4; ++m) { const float f = ds ? rt[(a * HALF + m * 16) * 4] : 1.f;
#pragma unroll
                    for (int b = 0; b < 2; ++b)
#pragma unroll
                        for (int n = 0; n < 2; ++n) acc[a][b][m][n] = acc[a][b][m][n] * f; }
        }
        }
        if (wr == 0) PG8_BAR;
        E(acc, cur, wr, wc, fr, fq);
        if (!has_next) break;
#pragma unroll
        for (int a = 0; a < 2; ++a)
#pragma unroll
            for (int b = 0; b < 2; ++b)
#pragma unroll
                for (int m = 0; m < 4; ++m)
#pragma unroll
                    for (int n = 0; n < 2; ++n) acc[a][b][m][n] = (f32x4){0.f, 0.f, 0.f, 0.f};
        cur = nxt; cA = nA; cB = nB; ++ui;
        if (wr == 1) PG8_BAR;
    }
    PG8_WAIT_V(0);
    PG8_BAR;
#undef PG8_SA
#undef PG8_SB
#undef PG8_STAGE
#undef PG8_LDA
#undef PG8_LDB
#undef PG8_MMA
#undef PG8_WAIT_V
#undef PG8_WAIT_L
#undef PG8_BAR
#undef PG8_SCHED
}
}
using pg8::Unit;
constexpr int HALF = 128, BM = 256;

struct EpiProj {
    static constexpr bool PERM = true;
    bf16_t* O; int ldc;
    __device__ __forceinline__ void operator()(const f32x4 (&acc)[2][2][4][2], const Unit& u, int wr, int wc, int fr, int fq) const {
        const int row0 = u.pm * BM + wr * 64 + fr, col0 = u.pn * BM + wc * 32 + 8 * fq;
#pragma unroll
        for (int ai = 0; ai < 2; ++ai)
#pragma unroll
            for (int m = 0; m < 4; ++m) { bf16_t* rowp = O + (size_t)(row0 + ai * HALF + m * 16) * ldc + col0;
#pragma unroll
                for (int bj = 0; bj < 2; ++bj) { const f32x4 v0 = acc[ai][bj][m][0], v1 = acc[ai][bj][m][1];
                    u32x4 w; w.x = pk2(v0[0], v0[1]); w.y = pk2(v0[2], v0[3]); w.z = pk2(v1[0], v1[1]); w.w = pk2(v1[2], v1[3]);
                    *(u32x4*)(rowp + bj * HALF) = w; } }
    }
};
struct EpiBr {
    static constexpr bool PERM = true;
    const bf16_t* proj; bf16_t* mix;
    __device__ __forceinline__ void operator()(const f32x4 (&acc)[2][2][4][2], const Unit& u, int wr, int wc, int fr, int fq) const {
        const int row0 = u.pm * BM + wr * 64 + fr, col0 = u.pn * BM + wc * 32 + 8 * fq;
        const int gbase = u.part == 0 ? C_GS : C_GA;
#pragma unroll
        for (int ai = 0; ai < 2; ++ai) {
#pragma unroll
            for (int mp = 0; mp < 2; ++mp) {
            u32x4 gw[2][2], pw[2][2];
#pragma unroll
            for (int mm = 0; mm < 2; ++mm) { const int row = row0 + ai * HALF + (2 * mp + mm) * 16;
#pragma unroll
                for (int bj = 0; bj < 2; ++bj) { const int col = col0 + bj * HALF;
                    gw[mm][bj] = *(const u32x4*)(proj + (size_t)row * PN + gbase + col);
                    pw[mm][bj] = u.part == 1 ? *(const u32x4*)(mix + (size_t)row * DM + col) : (u32x4){0u, 0u, 0u, 0u}; } }
#pragma unroll
            for (int mm = 0; mm < 2; ++mm) { const int m = 2 * mp + mm; const int row = row0 + ai * HALF + m * 16;
#pragma unroll
                for (int bj = 0; bj < 2; ++bj) { const int col = col0 + bj * HALF;
                    const u32x4 g = gw[mm][bj], p = pw[mm][bj];
                    const f32x4 v0 = acc[ai][bj][m][0], v1 = acc[ai][bj][m][1];
                    float r[8];
                    r[0] = sigmoidf_(bflo(g.x)) * v0[0] + bflo(p.x); r[1] = sigmoidf_(bfhi(g.x)) * v0[1] + bfhi(p.x); r[2] = sigmoidf_(bflo(g.y)) * v0[2] + bflo(p.y); r[3] = sigmoidf_(bfhi(g.y)) * v0[3] + bfhi(p.y);
                    r[4] = sigmoidf_(bflo(g.z)) * v1[0] + bflo(p.z); r[5] = sigmoidf_(bfhi(g.z)) * v1[1] + bfhi(p.z); r[6] = sigmoidf_(bflo(g.w)) * v1[2] + bflo(p.w); r[7] = sigmoidf_(bfhi(g.w)) * v1[3] + bfhi(p.w);
                    u32x4 w; w.x = pk2(r[0], r[1]); w.y = pk2(r[2], r[3]); w.z = pk2(r[4], r[5]); w.w = pk2(r[6], r[7]);
                    *(u32x4*)(mix + (size_t)row * DM + col) = w; } }
            }
        }
    }
};
struct EpiRes {
    static constexpr bool PERM = false;
    const float* xin_p; const float* xin_s; float* out; const float* gate; int row_base;
    __device__ __forceinline__ void operator()(const f32x4 (&acc)[2][2][4][2], const Unit& u, int wr, int wc, int fr, int fq) const {
        const int col0 = u.pn * BM + wc * 32 + 4 * fq;
#pragma unroll
        for (int ai = 0; ai < 2; ++ai) {
            const int grb = row_base + u.pm * BM + ai * HALF + wr * 64;
            const int seq = grb < MP ? (grb >> 11) : NPB + ((grb - MP) >> 6);
            const float* gp = gate + (size_t)seq * (6 * DM) + col0;
            f32x4 gv[2][2];
#pragma unroll
            for (int bj = 0; bj < 2; ++bj)
#pragma unroll
                for (int n = 0; n < 2; ++n) gv[bj][n] = *(const f32x4*)(gp + bj * HALF + n * 16);
            if (u.part == 0) {
#pragma unroll
                for (int mp = 0; mp < 2; ++mp) {
                f32x4 xv[2][2][2];
#pragma unroll
                for (int mm = 0; mm < 2; ++mm) { const int gr = grb + (2 * mp + mm) * 16 + fr;
                    const float* xr = (gr < MP ? xin_p + (size_t)gr * DM : xin_s + (size_t)(gr - MP) * DM) + col0;
#pragma unroll
                    for (int bj = 0; bj < 2; ++bj)
#pragma unroll
                        for (int n = 0; n < 2; ++n) xv[mm][bj][n] = *(const f32x4*)(xr + bj * HALF + n * 16); }
#pragma unroll
                for (int mm = 0; mm < 2; ++mm) { const int m = 2 * mp + mm; const int gr = grb + m * 16 + fr; float* orow = out + (size_t)gr * DM + col0;
#pragma unroll
                    for (int bj = 0; bj < 2; ++bj)
#pragma unroll
                        for (int n = 0; n < 2; ++n) *(f32x4*)(orow + bj * HALF + n * 16) = xv[mm][bj][n] + gv[bj][n] * acc[ai][bj][m][n]; }
                }
            } else {
#pragma unroll
                for (int m = 0; m < 4; ++m) { const int gr = grb + m * 16 + fr; float* orow = out + (size_t)gr * DM + col0;
#pragma unroll
                    for (int bj = 0; bj < 2; ++bj)
#pragma unroll
                        for (int n = 0; n < 2; ++n) { const f32x4 d = gv[bj][n] * acc[ai][bj][m][n]; float* o = orow + bj * HALF + n * 16;
                            __hip_atomic_fetch_add(o + 0, d[0], __ATOMIC_RELAXED, __HIP_MEMORY_SCOPE_AGENT); __hip_atomic_fetch_add(o + 1, d[1], __ATOMIC_RELAXED, __HIP_MEMORY_SCOPE_AGENT);
                            __hip_atomic_fetch_add(o + 2, d[2], __ATOMIC_RELAXED, __HIP_MEMORY_SCOPE_AGENT); __hip_atomic_fetch_add(o + 3, d[3], __ATOMIC_RELAXED, __HIP_MEMORY_SCOPE_AGENT); } }
            }
        }
    }
};
struct EpiSwiglu {
    static constexpr bool PERM = true;
    bf16_t* act;
    __device__ __forceinline__ void operator()(const f32x4 (&acc)[2][2][4][2], const Unit& u, int wr, int wc, int fr, int fq) const {
        const int row0 = u.pm * BM + wr * 64 + fr, col0 = u.pn * HALF + wc * 32 + 8 * fq;
#pragma unroll
        for (int ai = 0; ai < 2; ++ai)
#pragma unroll
            for (int m = 0; m < 4; ++m) { const int row = row0 + ai * HALF + m * 16;
                const f32x4 g0 = acc[ai][0][m][0], g1 = acc[ai][0][m][1], u0 = acc[ai][1][m][0], u1 = acc[ai][1][m][1];
                u32x4 w; w.x = pk2(siluf_(g0[0]) * u0[0], siluf_(g0[1]) * u0[1]); w.y = pk2(siluf_(g0[2]) * u0[2], siluf_(g0[3]) * u0[3]);
                w.z = pk2(siluf_(g1[0]) * u1[0], siluf_(g1[1]) * u1[1]); w.w = pk2(siluf_(g1[2]) * u1[2], siluf_(g1[3]) * u1[3]);
                *(u32x4*)(act + (size_t)row * DFF + col0) = w; }
    }
};

struct Args { const float* in[28]; float* out; unsigned char* ws; };

__device__ __forceinline__ float wave_sum(float v) {
#pragma unroll
    for (int o = 1; o < 64; o <<= 1) v += __shfl_xor(v, o);
    return v;
}

__device__ __forceinline__ void transpose_item(const float* __restrict__ W, int ldw, int src_c0, int k0, bf16_t* __restrict__ WT, int ldk, int drow0, int dk0, LAS float* scr, int lane, const float* __restrict__ kscale = nullptr) {
    if (src_c0 >= 0) {
#pragma unroll
        for (int i = 0; i < 32; ++i) { const int kk = 2 * i + (lane >> 5); scr[kk * 33 + (lane & 31)] = W[(size_t)(k0 + kk) * ldw + src_c0 + (lane & 31)] * (kscale ? kscale[k0 + kk] : 1.f); }
    } else {
#pragma unroll 8
        for (int i = 0; i < 32; ++i) { const int kk = 2 * i + (lane >> 5); scr[kk * 33 + (lane & 31)] = 0.f; }
    }
    LDS_WAIT(); asm volatile("" ::: "memory");
    const int c = lane & 7;
#pragma unroll
    for (int j = 0; j < 4; ++j) { const int n = (lane >> 3) + 8 * j; const LAS float* s = scr + (8 * c) * 33 + n;
        u32x4 o; o.x = pk2(s[0 * 33], s[1 * 33]); o.y = pk2(s[2 * 33], s[3 * 33]); o.z = pk2(s[4 * 33], s[5 * 33]); o.w = pk2(s[6 * 33], s[7 * 33]);
        *(u32x4*)(WT + (size_t)(drow0 + n) * ldk + dk0 + k0 + 8 * c) = o; }
    LDS_WAIT(); asm volatile("" ::: "memory");
}

__device__ __forceinline__ void prologue_weights(const Args& a, LAS unsigned char* lds, int gw, int NGW, int wave, int lane) {
    LAS float* scr = (LAS float*)(lds + wave * 16384);
    constexpr int I_IN = 16 * (PN / 32), I_BS = 32 * 32, I_BA = 16 * 32, I_O = 16 * 32, I_GU = 16 * (2 * DFF / 32), I_D = (DFF / 64) * 32;
    constexpr int PER_LAYER = I_IN + I_BS + I_BA + I_O + I_GU + I_D;
    for (int it = gw; it < 2 * PER_LAYER; it += NGW) {
        const int l = it / PER_LAYER; int r = it - l * PER_LAYER;
        unsigned char* wl = a.ws + (size_t)l * W_LAYER;
        if (r < I_IN) { const int nblk = PN / 32, kb = r / nblk, nb = r % nblk, n0 = nb * 32;
            const int src = n0 < 5120 ? n0 : (n0 < 8704 ? n0 + 32 : (n0 < 8736 ? 5120 : -1));
            transpose_item(a.in[13] + (size_t)l * DM * INCOLS, INCOLS, src, kb * 64, (bf16_t*)(wl + W_IN), DM, n0, 0, scr, lane); continue; } r -= I_IN;
        if (r < I_BS) { const int kb = r / 32, nb = r % 32;
            transpose_item(a.in[23] + (size_t)l * DIN * DM, DM, nb * 32, kb * 64, (bf16_t*)(wl + W_BR), 3072, nb * 32, 0, scr, lane, a.in[19] + l * DIN); continue; } r -= I_BS;
        if (r < I_BA) { const int kb = r / 32, nb = r % 32;
            transpose_item(a.in[24] + (size_t)l * DM * DM, DM, nb * 32, kb * 64, (bf16_t*)(wl + W_BR), 3072, nb * 32, 2048, scr, lane); continue; } r -= I_BA;
        if (r < I_O) { const int kb = r / 32, nb = r % 32;
            transpose_item(a.in[25] + (size_t)l * DM * DM, DM, nb * 32, kb * 64, (bf16_t*)(wl + W_O), DM, nb * 32, 0, scr, lane); continue; } r -= I_O;
        if (r < I_GU) { const int nblk = 2 * DFF / 32, kb = r / nblk, nb = r % nblk, n0 = nb * 32, j = n0 >> 8, rr = n0 & 255;
            const int src = rr < 128 ? j * 128 + rr : DFF + j * 128 + (rr - 128);
            transpose_item(a.in[26] + (size_t)l * DM * 2 * DFF, 2 * DFF, src, kb * 64, (bf16_t*)(wl + W_GU), DM, n0, 0, scr, lane); continue; } r -= I_GU;
        { const int kb = r / 32, nb = r % 32;
            transpose_item(a.in[27] + (size_t)l * DFF * DM, DM, nb * 32, kb * 64, (bf16_t*)(wl + W_D), DFF, nb * 32, 0, scr, lane); }
    }
}

__device__ __forceinline__ void prologue_mod_item(const Args& a, LAS unsigned char* lds, int item, int tid) {
    const int l = item / 96, n0 = (item % 96) * 64;
    const float* W = a.in[9] + (size_t)l * DM * (6 * DM);
    LAS float* sl = (LAS float*)lds;
    const int col = tid & 63, kp = tid >> 6;
    f32x2 acc[NSEQ / 2];
#pragma unroll
    for (int s = 0; s < NSEQ / 2; ++s) acc[s] = (f32x2){0.f, 0.f};
    for (int half = 0; half < 2; ++half) {
        __syncthreads();
        for (int idx = tid; idx < 512 * NSEQ; idx += 512) { const int s = idx >> 9, kl = idx & 511, k = half * 512 + kl;
            const float v = s < NPB ? a.in[6][s * DM + k] : a.in[7][(s - NPB) * DM + k];
            sl[kl * NSEQ + s] = siluf_(v); }
        __syncthreads();
#pragma unroll 16
        for (int kk = 0; kk < 64; ++kk) { const int kl = kp * 64 + kk;
            const float w = W[(size_t)(half * 512 + kl) * (6 * DM) + n0 + col];
            const LAS f32x4* sp = (const LAS f32x4*)(sl + kl * NSEQ);
#pragma unroll
            for (int q = 0; q < NSEQ / 4; ++q) { const f32x4 sv = sp[q]; const f32x2 w2 = (f32x2){w, w};
                acc[2 * q] = __builtin_elementwise_fma((f32x2){sv[0], sv[1]}, w2, acc[2 * q]); acc[2 * q + 1] = __builtin_elementwise_fma((f32x2){sv[2], sv[3]}, w2, acc[2 * q + 1]); } }
    }
    __syncthreads();
#pragma unroll
    for (int s = 0; s < NSEQ; ++s) sl[(kp * NSEQ + s) * 64 + col] = acc[s >> 1][s & 1];
    __syncthreads();
    float* mod = (float*)(a.ws + WS_MOD) + (size_t)l * NSEQ * (6 * DM);
    for (int o = tid; o < NSEQ * 64; o += 512) { const int s = o >> 6, c = o & 63; float v = a.in[10][l * (6 * DM) + n0 + c];
#pragma unroll
        for (int p = 0; p < 8; ++p) v += sl[(p * NSEQ + s) * 64 + c];
        mod[(size_t)s * (6 * DM) + n0 + c] = v; }
    __syncthreads();
}

__device__ __forceinline__ void norm_mod_rows(const float* __restrict__ xp, const float* __restrict__ xs, const float* __restrict__ gvec, const float* __restrict__ mod, int ch_shift, int ch_scale,
                                              bf16_t* __restrict__ H, int row_base, int nrows, int gw, int NGW, int lane) {
    for (int r0 = gw; r0 < nrows; r0 += 2 * NGW) {
        const int r1 = r0 + NGW; const bool two = r1 < nrows;
        const int gr0 = row_base + r0, gr1 = row_base + (two ? r1 : r0);
        const float* xrow0 = gr0 < MP ? xp + (size_t)gr0 * DM : xs + (size_t)(gr0 - MP) * DM;
        const float* xrow1 = gr1 < MP ? xp + (size_t)gr1 * DM : xs + (size_t)(gr1 - MP) * DM;
        f32x4 v0[4], v1[4]; float s0 = 0.f, s1 = 0.f;
#pragma unroll
        for (int j = 0; j < 4; ++j) { v0[j] = ((const f32x4*)xrow0)[lane + 64 * j]; v1[j] = ((const f32x4*)xrow1)[lane + 64 * j]; }
#pragma unroll
        for (int j = 0; j < 4; ++j) { s0 += (v0[j][0] * v0[j][0] + v0[j][1] * v0[j][1]) + (v0[j][2] * v0[j][2] + v0[j][3] * v0[j][3]);
                                      s1 += (v1[j][0] * v1[j][0] + v1[j][1] * v1[j][1]) + (v1[j][2] * v1[j][2] + v1[j][3] * v1[j][3]); }
        const float rstd0 = rsqrtf(wave_sum(s0) * (1.f / DM) + EPS), rstd1 = rsqrtf(wave_sum(s1) * (1.f / DM) + EPS);
#pragma unroll
        for (int q = 0; q < 2; ++q) {
            if (q == 1 && !two) break;
            const int gr = q ? gr1 : gr0, r = q ? r1 : r0; const float rstd = q ? rstd1 : rstd0;
            const int seq = gr < MP ? (gr >> 11) : NPB + ((gr - MP) >> 6);
            const float* mrow = mod + (size_t)seq * (6 * DM);
            u32x2* o8 = (u32x2*)(H + (size_t)r * DM);
            f32x4 gq[4], scq[4], shq[4];
#pragma unroll
            for (int j = 0; j < 4; ++j) { const int ci = lane + 64 * j;
                gq[j] = ((const f32x4*)gvec)[ci]; scq[j] = ((const f32x4*)(mrow + ch_scale * DM))[ci]; shq[j] = ((const f32x4*)(mrow + ch_shift * DM))[ci]; }
#pragma unroll
            for (int j = 0; j < 4; ++j) { const int ci = lane + 64 * j;
                const f32x4 y = ((q ? v1[j] : v0[j]) * rstd) * gq[j] * (scq[j] + 1.f) + shq[j];
                u32x2 w; w.x = pk2(y[0], y[1]); w.y = pk2(y[2], y[3]); o8[ci] = w; }
        }
    }
}

__device__ __forceinline__ void ynorm_rows(bf16_t* proj, const float* ssq, const float* gvec, int nrows, int gw, int NGW, int lane) {
    for (int r0 = gw; r0 < nrows; r0 += 2 * NGW) {
        const int r1 = (r0 + NGW < nrows) ? r0 + NGW : r0; const bool two = r1 != r0;
        float q0 = lane < 32 ? ssq[(size_t)r0 * NH + lane] : 0.f, q1 = lane < 32 ? ssq[(size_t)r1 * NH + lane] : 0.f;
        u32x4* row0 = (u32x4*)(proj + (size_t)r0 * PN); u32x4* row1 = (u32x4*)(proj + (size_t)r1 * PN);
        u32x4 w0[4], w1[4];
#pragma unroll
        for (int j = 0; j < 4; ++j) { w0[j] = row0[j * 64 + lane]; w1[j] = row1[j * 64 + lane]; }
        q0 += __shfl_xor(q0, 1); q0 += __shfl_xor(q0, 2); q0 += __shfl_xor(q0, 4);
        q1 += __shfl_xor(q1, 1); q1 += __shfl_xor(q1, 2); q1 += __shfl_xor(q1, 4);
        const float rs0 = rsqrtf(q0 * (1.f / 512.f) + EPS), rs1 = rsqrtf(q1 * (1.f / 512.f) + EPS);
#pragma unroll
        for (int j = 0; j < 4; ++j) { const int ci = j * 64 + lane;
            const f32x4 g0 = ((const f32x4*)gvec)[2 * ci], g1 = ((const f32x4*)gvec)[2 * ci + 1];
            { const float rj = __shfl(rs0, j * 8); const u32x4 w = w0[j];
              u32x4 o; o.x = pk2(bflo(w.x) * rj * g0[0], bfhi(w.x) * rj * g0[1]); o.y = pk2(bflo(w.y) * rj * g0[2], bfhi(w.y) * rj * g0[3]);
              o.z = pk2(bflo(w.z) * rj * g1[0], bfhi(w.z) * rj * g1[1]); o.w = pk2(bflo(w.w) * rj * g1[2], bfhi(w.w) * rj * g1[3]); row0[ci] = o; }
            { const float rj = __shfl(rs1, j * 8); const u32x4 w = w1[j];
              u32x4 o; o.x = pk2(bflo(w.x) * rj * g0[0], bfhi(w.x) * rj * g0[1]); o.y = pk2(bflo(w.y) * rj * g0[2], bfhi(w.y) * rj * g0[3]);
              o.z = pk2(bflo(w.z) * rj * g1[0], bfhi(w.z) * rj * g1[1]); o.w = pk2(bflo(w.w) * rj * g1[2], bfhi(w.w) * rj * g1[3]); if (two) row1[ci] = o; }
        }
    }
}

__device__ __forceinline__ void convbc_item(const Args& a, int layer, bool is_sample, int b, int cg32, int seq_row0, bf16_t* proj, const int tid) {
    const int oc = is_sample ? (tid & 15) : (tid & 3), ts = is_sample ? (tid >> 4) : (tid >> 2);
    const int L = is_sample ? DSEQ : SEQ, seglen = is_sample ? 2 : 16;
    const bool act = true;
    const int ch = DIN + (is_sample ? cg32 * 128 : cg32 * 32) + oc * 8;
    const int t0 = ts * seglen;
    u32x4 rw[19];
    float cw[4][8], cb[8];
    if (act) {
        const float* wp = a.in[14] + (size_t)layer * 4 * CONVC + ch; const float* bp = a.in[15] + (size_t)layer * CONVC + ch;
#pragma unroll
        for (int k = 0; k < 4; ++k) { const f32x4 w0 = *(const f32x4*)(wp + k * CONVC), w1 = *(const f32x4*)(wp + k * CONVC + 4);
            cw[k][0] = w0[0]; cw[k][1] = w0[1]; cw[k][2] = w0[2]; cw[k][3] = w0[3]; cw[k][4] = w1[0]; cw[k][5] = w1[1]; cw[k][6] = w1[2]; cw[k][7] = w1[3]; }
        const f32x4 b0 = *(const f32x4*)bp, b1 = *(const f32x4*)(bp + 4);
        cb[0] = b0[0]; cb[1] = b0[1]; cb[2] = b0[2]; cb[3] = b0[3]; cb[4] = b1[0]; cb[5] = b1[1]; cb[6] = b1[2]; cb[7] = b1[3];
#pragma unroll
        for (int r = 0; r < 19; ++r) {
            const int tt = t0 - 3 + r;
            if (r < 3 + seglen) {
                if (tt >= 0) rw[r] = *(const u32x4*)(proj + (size_t)(seq_row0 + tt) * PN + C_XBC + ch);
                else if (is_sample) { const float* pp = a.in[4] + ((size_t)(layer * NSB + b) * 3 + (3 + tt)) * CONVC + ch;
                    const f32x4 p0 = *(const f32x4*)pp, p1 = *(const f32x4*)(pp + 4);
                    rw[r].x = pk2(p0[0], p0[1]); rw[r].y = pk2(p0[2], p0[3]); rw[r].z = pk2(p1[0], p1[1]); rw[r].w = pk2(p1[2], p1[3]); }
                else rw[r] = (u32x4){0u, 0u, 0u, 0u};
            }
        }
    }
    __syncthreads();
    if (act) {
        float* nc = a.out + (is_sample ? O_CONVS + (size_t)(layer * NSB + b) * 3 * CONVC : O_CONVP + (size_t)(layer * NPB + b) * 3 * CONVC) + ch;
#pragma unroll
        for (int t = 0; t < 16; ++t) {
            if (t < seglen) {
                float o[8];
#pragma unroll
                for (int i = 0; i < 8; ++i) o[i] = cb[i];
#pragma unroll
                for (int k = 0; k < 4; ++k) { const u32x4 w = rw[t + k];
                    o[0] += cw[k][0] * bflo(w.x); o[1] += cw[k][1] * bfhi(w.x); o[2] += cw[k][2] * bflo(w.y); o[3] += cw[k][3] * bfhi(w.y);
                    o[4] += cw[k][4] * bflo(w.z); o[5] += cw[k][5] * bfhi(w.z); o[6] += cw[k][6] * bflo(w.w); o[7] += cw[k][7] * bfhi(w.w); }
                u32x4 w; w.x = pk2(siluf_(o[0]), siluf_(o[1])); w.y = pk2(siluf_(o[2]), siluf_(o[3])); w.z = pk2(siluf_(o[4]), siluf_(o[5])); w.w = pk2(siluf_(o[6]), siluf_(o[7]));
                *(u32x4*)(proj + (size_t)(seq_row0 + t0 + t) * PN + C_XBC + ch) = w;
                const int tl = t0 + t - (L - 3);
                if (tl >= 0) { const u32x4 rr = rw[t + 3]; float* q = nc + (size_t)tl * CONVC;
                    *(f32x4*)q = (f32x4){bflo(rr.x), bfhi(rr.x), bflo(rr.y), bfhi(rr.y)}; *(f32x4*)(q + 4) = (f32x4){bflo(rr.z), bfhi(rr.z), bflo(rr.w), bfhi(rr.w)}; }
            }
        }
    }
}

constexpr int P64 = 144, P128 = 272;
constexpr int L_XST = 0, L_G = L_XST + 64 * P64, L_CM = L_G + 64 * P64, L_BM = L_CM + 64 * P128, L_BWT = L_BM + 64 * P128,
              L_ST = L_BWT + 128 * P64, L_ZT = L_ST + 64 * P128, L_XRAW = L_ZT + 64 * P64, L_DT = L_XRAW + 68 * P64, L_AC = L_DT + 8192,
              L_SSQ = L_AC + 8192, L_SSQA = L_SSQ + 512, L_SSD_END = L_SSQA + 8192;
static_assert(L_SSD_END <= LDS_BYTES - 256, "ssd lds");
constexpr unsigned SSD_STEP = 64u * PN * 2u;

__device__ __forceinline__ void ssd_item(const Args& a, LAS unsigned char* lds, int layer, bool is_sample, int b, int h, int seq_row0, int nchunks,
                                         bf16_t* proj, float* ssq, const int tid) {
    const int wave = __builtin_amdgcn_readfirstlane(tid >> 6), lane = tid & 63, fr = lane & 15, fq = lane >> 4;
    const int grp = h >> 3, tok = tid >> 3, oct = tid & 7;
    float cw[4][8], cb[8];
    {
        const int chx = h * 64 + wave * 8;
        const float* wp = a.in[14] + (size_t)layer * 4 * CONVC + chx; const float* bp = a.in[15] + (size_t)layer * CONVC + chx;
#pragma unroll
        for (int k = 0; k < 4; ++k) { const f32x4 w0 = *(const f32x4*)(wp + k * CONVC), w1 = *(const f32x4*)(wp + k * CONVC + 4);
            cw[k][0] = w0[0]; cw[k][1] = w0[1]; cw[k][2] = w0[2]; cw[k][3] = w0[3]; cw[k][4] = w1[0]; cw[k][5] = w1[1]; cw[k][6] = w1[2]; cw[k][7] = w1[3]; }
        const f32x4 b0 = *(const f32x4*)bp, b1 = *(const f32x4*)(bp + 4);
        cb[0] = b0[0]; cb[1] = b0[1]; cb[2] = b0[2]; cb[3] = b0[3]; cb[4] = b1[0]; cb[5] = b1[1]; cb[6] = b1[2]; cb[7] = b1[3];
    }
    const float dtb = a.in[16][layer * NH + h], Aneg = -__expf(a.in[17][layer * NH + h]), dsk = a.in[18][layer * NH + h];
    const int pb = wave >> 1, nb0 = (wave & 1) * 4, rb = wave >> 1;
    f32x4 st[4];
    float* ssm_out = a.out + (is_sample ? O_SSMS + ((size_t)(layer * NSB + b) * NH + h) * 8192 : O_SSMP + ((size_t)(layer * NPB + b) * NH + h) * 8192);
    if (is_sample) {
        const float* sp = a.in[5] + ((size_t)(layer * NSB + b) * NH + h) * 8192;
#pragma unroll
        for (int i = 0; i < 4; ++i)
            st[i] = *(const f32x4*)(sp + (16 * pb + fr) * DSTATE + 16 * (nb0 + i) + 4 * fq);
    } else {
#pragma unroll
        for (int i = 0; i < 4; ++i) st[i] = (f32x4){0.f, 0.f, 0.f, 0.f};
    }
    LAS float* dt_all = (LAS float*)(lds + L_DT); LAS float* ac_all = (LAS float*)(lds + L_AC);
    LAS float* ssqp = (LAS float*)(lds + L_SSQ);
    const char* pbase = (const char*)proj;
    const unsigned off_x = (unsigned)((seq_row0 + tok) * PN + C_XBC + h * 64 + oct * 8) * 2u;
    const unsigned off_b = (unsigned)((seq_row0 + (tid >> 4) * 2) * PN + C_XBC + DIN + grp * DSTATE + (tid & 15) * 8) * 2u;
    const unsigned off_z = (unsigned)((seq_row0 + tok) * PN + C_Z + h * 64 + oct * 8) * 2u;
    u32x4 xv, xh = (u32x4){0u, 0u, 0u, 0u}, bv0, bv1, cv0, cv1, zv;
    xv = *(const u32x4*)(pbase + off_x); bv0 = *(const u32x4*)(pbase + off_b); bv1 = *(const u32x4*)(pbase + off_b + PN * 2); cv0 = *(const u32x4*)(pbase + off_b + 1024); cv1 = *(const u32x4*)(pbase + off_b + PN * 2 + 1024);
    zv = *(const u32x4*)(pbase + off_z);
    {
        bf16_t dr[4];
#pragma unroll
        for (int q = 0; q < 4; ++q) { const int cc = wave + 8 * q; dr[q] = cc < nchunks ? proj[(size_t)(seq_row0 + cc * 64 + lane) * PN + C_DT + h] : (bf16_t)0; }
#pragma unroll
        for (int q = 0; q < 4; ++q) { const int cc = wave + 8 * q;
            if (cc < nchunks) {
                const float x = bf2f(dr[q]) + dtb;
                const float dt = x > 20.f ? x : log1pf(__expf(x));
                float sc = dt * Aneg;
#pragma unroll
                for (int off = 1; off < 64; off <<= 1) { const float v = __shfl_up(sc, off); if (lane >= off) sc += v; }
                dt_all[cc * 64 + lane] = dt; ac_all[cc * 64 + lane] = sc * 1.4426950408889634f; } }
    }
    if (is_sample && tid < 24) { const float* pp = a.in[4] + ((size_t)(layer * NSB + b) * 3 + tok) * CONVC + h * 64 + oct * 8;
        const f32x4 p0 = *(const f32x4*)pp, p1 = *(const f32x4*)(pp + 4);
        xh.x = pk2(p0[0], p0[1]); xh.y = pk2(p0[2], p0[3]); xh.z = pk2(p1[0], p1[1]); xh.w = pk2(p1[2], p1[3]); }
#pragma unroll 1
    for (int c = 0; c < nchunks; ++c) {
        const unsigned cs = (unsigned)c * SSD_STEP;
        const LAS float* dtv = dt_all + c * 64; const LAS float* acv = ac_all + c * 64;
        *(LAS u32x4*)(lds + L_XRAW + (3 + tok) * P64 + oct * 16) = xv;
        if (tid < 24) *(LAS u32x4*)(lds + L_XRAW + tok * P64 + oct * 16) = xh;
        { const int oc = tid & 15, tk = (tid >> 4) * 2;
          *(LAS u32x4*)(lds + L_BM + tk * P128 + oc * 16) = bv0; *(LAS u32x4*)(lds + L_BM + (tk + 1) * P128 + oc * 16) = bv1;
          *(LAS u32x4*)(lds + L_CM + tk * P128 + oc * 16) = cv0; *(LAS u32x4*)(lds + L_CM + (tk + 1) * P128 + oc * 16) = cv1; }
        {
            const u32x4 yv = *(const LAS u32x4*)(lds + L_ZT + tok * P64 + oct * 16);
            *(LAS u32x4*)(lds + L_ZT + tok * P64 + oct * 16) = zv;
            if (c > 0) *(u32x4*)(const_cast<char*>(pbase) + off_z + cs - SSD_STEP) = yv; }
#pragma unroll
        for (int i = 0; i < 4; ++i) { u32x2 w; w.x = pk2(st[i][0], st[i][1]); w.y = pk2(st[i][2], st[i][3]);
            *(LAS u32x2*)(lds + L_ST + (16 * pb + fr) * P128 + (16 * (nb0 + i) + 4 * fq) * 2) = w; }
        LBAR();
        const u32x4 bo0 = bv0, bo1 = bv1;
        if (c + 1 < nchunks) {
            const unsigned cn = cs + SSD_STEP;
            xv = *(const u32x4*)(pbase + off_x + cn); if (tid < 24) xh = *(const u32x4*)(pbase + off_x + cn - 3u * PN * 2u);
            bv0 = *(const u32x4*)(pbase + off_b + cn); bv1 = *(const u32x4*)(pbase + off_b + cn + PN * 2); cv0 = *(const u32x4*)(pbase + off_b + cn + 1024); cv1 = *(const u32x4*)(pbase + off_b + cn + PN * 2 + 1024);
            zv = *(const u32x4*)(pbase + off_z + cn);
        }
        {
            float o[8];
#pragma unroll
            for (int i = 0; i < 8; ++i) o[i] = cb[i];
#pragma unroll
            for (int k = 0; k < 4; ++k) { const u32x4 w = *(const LAS u32x4*)(lds + L_XRAW + (lane + k) * P64 + wave * 16);
                o[0] += cw[k][0] * bflo(w.x); o[1] += cw[k][1] * bfhi(w.x); o[2] += cw[k][2] * bflo(w.y); o[3] += cw[k][3] * bfhi(w.y);
                o[4] += cw[k][4] * bflo(w.z); o[5] += cw[k][5] * bfhi(w.z); o[6] += cw[k][6] * bflo(w.w); o[7] += cw[k][7] * bfhi(w.w); }
#pragma unroll
            for (int i = 0; i < 8; ++i) *(LAS bf16_t*)(lds + L_XST + (wave * 8 + i) * P64 + lane * 2) = f2bf(siluf_(o[i]));
        }
        {
            const int oc = tid & 15, tk = (tid >> 4) * 2;
            const float a63s = acv[63]; const float wa = dtv[tk] * __builtin_amdgcn_exp2f(a63s - acv[tk]), wb = dtv[tk + 1] * __builtin_amdgcn_exp2f(a63s - acv[tk + 1]);
            LAS unsigned char* d = lds + L_BWT + (oc * 8) * P64 + ((((tk >> 3) ^ ((oc >> 1) & 7)) << 4) | ((tk * 2) & 15));
            *(LAS unsigned*)(d + 0 * P64) = pk2(bflo(bo0.x) * wa, bflo(bo1.x) * wb); *(LAS unsigned*)(d + 1 * P64) = pk2(bfhi(bo0.x) * wa, bfhi(bo1.x) * wb);
            *(LAS unsigned*)(d + 2 * P64) = pk2(bflo(bo0.y) * wa, bflo(bo1.y) * wb); *(LAS unsigned*)(d + 3 * P64) = pk2(bfhi(bo0.y) * wa, bfhi(bo1.y) * wb);
            *(LAS unsigned*)(d + 4 * P64) = pk2(bflo(bo0.z) * wa, bflo(bo1.z) * wb); *(LAS unsigned*)(d + 5 * P64) = pk2(bfhi(bo0.z) * wa, bfhi(bo1.z) * wb);
            *(LAS unsigned*)(d + 6 * P64) = pk2(bflo(bo0.w) * wa, bflo(bo1.w) * wb); *(LAS unsigned*)(d + 7 * P64) = pk2(bfhi(bo0.w) * wa, bfhi(bo1.w) * wb);
        }
        {
            float al[4];
#pragma unroll
            for (int j = 0; j < 4; ++j) al[j] = acv[16 * rb + 4 * fq + j];
#pragma unroll
            for (int ci = 0; ci < 2; ++ci) { const int cbk = (wave & 1) * 2 + ci; f32x4 acc = (f32x4){0.f, 0.f, 0.f, 0.f};
#pragma unroll
                for (int ks = 0; ks < 4; ++ks) { const bf16x8 av = *(const LAS bf16x8*)(lds + L_CM + (16 * rb + fr) * P128 + (32 * ks + 8 * fq) * 2);
                    const bf16x8 bv = *(const LAS bf16x8*)(lds + L_BM + (16 * cbk + fr) * P128 + (32 * ks + 8 * fq) * 2); acc = mfma16(av, bv, acc); }
                const int s = 16 * cbk + fr; const float as = acv[s], ds = dtv[s];
#pragma unroll
                for (int j = 0; j < 4; ++j) { const int l = 16 * rb + 4 * fq + j;
                    const float gv = (s <= l) ? acc[j] * __builtin_amdgcn_exp2f(al[j] - as) * ds : 0.f;
                    *(LAS bf16_t*)(lds + L_G + l * P64 + s * 2) = f2bf(gv); } }
        }
        LBAR();
        {
            float sq[4] = {0.f, 0.f, 0.f, 0.f}, el[4];
#pragma unroll
            for (int j = 0; j < 4; ++j) el[j] = __builtin_amdgcn_exp2f(acv[16 * rb + 4 * fq + j]);
#pragma unroll
            for (int ci = 0; ci < 2; ++ci) { const int cbk = (wave & 1) * 2 + ci; f32x4 acc = (f32x4){0.f, 0.f, 0.f, 0.f}, acp = (f32x4){0.f, 0.f, 0.f, 0.f};
#pragma unroll
                for (int ks = 0; ks < 2; ++ks) { const bf16x8 av = *(const LAS bf16x8*)(lds + L_G + (16 * rb + fr) * P64 + (32 * ks + 8 * fq) * 2);
                    const bf16x8 bv = *(const LAS bf16x8*)(lds + L_XST + (16 * cbk + fr) * P64 + (32 * ks + 8 * fq) * 2); acc = mfma16(av, bv, acc); }
#pragma unroll
                for (int ks = 0; ks < 4; ++ks) { const bf16x8 av = *(const LAS bf16x8*)(lds + L_CM + (16 * rb + fr) * P128 + (32 * ks + 8 * fq) * 2);
                    const bf16x8 bv = *(const LAS bf16x8*)(lds + L_ST + (16 * cbk + fr) * P128 + (32 * ks + 8 * fq) * 2); acp = mfma16(av, bv, acp); }
                const int p = 16 * cbk + fr;
                const u32x2 xs4 = *(const LAS u32x2*)(lds + L_XST + p * P64 + (16 * rb + 4 * fq) * 2);
                const float xsv[4] = {bflo(xs4.x), bfhi(xs4.x), bflo(xs4.y), bfhi(xs4.y)};
#pragma unroll
                for (int j = 0; j < 4; ++j) { const int l = 16 * rb + 4 * fq + j;
                    LAS bf16_t* zp = (LAS bf16_t*)(lds + L_ZT + l * P64 + p * 2);
                    const float z = bf2f(*zp);
                    const float yg = (acc[j] + el[j] * acp[j] + xsv[j] * dsk) * siluf_(z);
                    *zp = f2bf(yg); sq[j] += yg * yg; } }
#pragma unroll
            for (int j = 0; j < 4; ++j) { const float v = row16_sum(sq[j]);
                if (fr == 0) ssqp[(16 * rb + 4 * fq + j) * 2 + (wave & 1)] = v; }
            const float dec = __builtin_amdgcn_exp2f(acv[63]);
#pragma unroll
            for (int i = 0; i < 4; ++i) { st[i] = st[i] * dec;
#pragma unroll
                for (int ks = 0; ks < 2; ++ks) { const bf16x8 av = *(const LAS bf16x8*)(lds + L_XST + (16 * pb + fr) * P64 + (32 * ks + 8 * fq) * 2);
                    const bf16x8 bv = *(const LAS bf16x8*)(lds + L_BWT + (16 * (nb0 + i) + fr) * P64 + (((4 * ks + fq) ^ ((nb0 + i) & 7)) << 4)); st[i] = mfma16(bv, av, st[i]); } }
        }
        LBAR();
        if (tid < 64) ((LAS float*)(lds + L_SSQA))[c * 64 + tid] = ssqp[tid * 2] + ssqp[tid * 2 + 1];
    }
    LBAR();
    for (int t = tid; t < nchunks * 64; t += 512) ssq[(size_t)(seq_row0 + t) * NH + h] = ((const LAS float*)(lds + L_SSQA))[t];
    { const u32x4 yv = *(const LAS u32x4*)(lds + L_ZT + tok * P64 + oct * 16); *(u32x4*)(const_cast<char*>(pbase) + off_z + (unsigned)(nchunks - 1) * SSD_STEP) = yv; }
#pragma unroll
    for (int i = 0; i < 4; ++i) *(f32x4*)(ssm_out + (16 * pb + fr) * DSTATE + 16 * (nb0 + i) + 4 * fq) = st[i];
    LBAR();
}

constexpr int PK = 144, PV = 400;
constexpr int L_KS = 0, L_VT = L_KS + 192 * PK, L_BT = L_VT + 64 * PV, L_ATT_END = L_BT + 4 * 256 * 4;
static_assert(L_ATT_END <= 131072, "attn lds");

__device__ __forceinline__ void attn_item(const Args& a, LAS unsigned char* lds, int layer, bool is_sample, int b, int c, int kvh, int seq_row0, int nchunks, bf16_t* proj, const int tid) {
    const int wave = __builtin_amdgcn_readfirstlane(tid >> 6), lane = tid & 63, fr = lane & 15, fq = lane >> 4;
    const int row0 = seq_row0 + c * 64;
    const float* kng = a.in[21] + layer * 64;
    u32x4 qraw[2][2];
    {
        const int hq_ = kvh * 4 + (wave >> 1);
#pragma unroll
        for (int sub = 0; sub < 2; ++sub) { const bf16_t* qp_ = proj + (size_t)(row0 + (wave & 1) * 32 + sub * 16 + fr) * PN + C_Q + hq_ * 64;
#pragma unroll
            for (int ks = 0; ks < 2; ++ks) qraw[sub][ks] = *(const u32x4*)(qp_ + 32 * ks + 8 * fq); }
    }
#pragma unroll
    for (int i = 0; i < 3; ++i) {
        const int slot = tid + 512 * i, kl = slot >> 3, oc = slot & 7;
        const int pos = c * 64 - 128 + kl;
        float kf[8], vf[8];
        if (is_sample && kl < 128) {
            const size_t off = (((size_t)(layer * NSB + b) * 128 + kl) * NKVH + kvh) * 64 + oc * 8;
            const f32x4 k0 = *(const f32x4*)(a.in[2] + off), k1 = *(const f32x4*)(a.in[2] + off + 4), v0 = *(const f32x4*)(a.in[3] + off), v1 = *(const f32x4*)(a.in[3] + off + 4);
#pragma unroll
            for (int e = 0; e < 4; ++e) { kf[e] = k0[e]; kf[4 + e] = k1[e]; vf[e] = v0[e]; vf[4 + e] = v1[e]; }
        } else if (pos >= 0) {
            const bf16_t* rp = proj + (size_t)(seq_row0 + pos) * PN;
            const u32x4 kw = *(const u32x4*)(rp + C_K + kvh * 64 + oc * 8), vw = *(const u32x4*)(rp + C_V + kvh * 64 + oc * 8);
            kf[0] = bflo(kw.x); kf[1] = bfhi(kw.x); kf[2] = bflo(kw.y); kf[3] = bfhi(kw.y); kf[4] = bflo(kw.z); kf[5] = bfhi(kw.z); kf[6] = bflo(kw.w); kf[7] = bfhi(kw.w);
            vf[0] = bflo(vw.x); vf[1] = bfhi(vw.x); vf[2] = bflo(vw.y); vf[3] = bfhi(vw.y); vf[4] = bflo(vw.z); vf[5] = bfhi(vw.z); vf[6] = bflo(vw.w); vf[7] = bfhi(vw.w);
            float ss = 0.f;
#pragma unroll
            for (int e = 0; e < 8; ++e) ss += kf[e] * kf[e];
            ss += __shfl_xor(ss, 1); ss += __shfl_xor(ss, 2); ss += __shfl_xor(ss, 4);
            const float rs = rsqrtf(ss * (1.f / 64.f) + EPS);
            const f32x4 g0 = *(const f32x4*)(kng + oc * 8), g1 = *(const f32x4*)(kng + oc * 8 + 4);
#pragma unroll
            for (int e = 0; e < 4; ++e) { kf[e] = kf[e] * rs * g0[e]; kf[4 + e] = kf[4 + e] * rs * g1[e]; }
            if (kl >= 128 && (is_sample || c >= nchunks - 2)) {
                const int orow = is_sample ? (kl - 128) : (c - (nchunks - 2)) * 64 + (kl - 128);
                const size_t nb_ = is_sample ? NSB : NPB; const int lr = is_sample ? DSEQ : 128;
                const size_t off = (((size_t)(layer * nb_ + b) * lr + orow) * NKVH + kvh) * 64 + oc * 8;
                float* ko = a.out + (is_sample ? O_KS : O_KP) + off; float* vo = a.out + (is_sample ? O_VS : O_VP) + off;
                *(f32x4*)ko = (f32x4){kf[0], kf[1], kf[2], kf[3]}; *(f32x4*)(ko + 4) = (f32x4){kf[4], kf[5], kf[6], kf[7]};
                *(f32x4*)vo = (f32x4){vf[0], vf[1], vf[2], vf[3]}; *(f32x4*)(vo + 4) = (f32x4){vf[4], vf[5], vf[6], vf[7]};
            }
        } else {
#pragma unroll
            for (int e = 0; e < 8; ++e) { kf[e] = 0.f; vf[e] = 0.f; }
        }
        u32x4 w; w.x = pk2(kf[0], kf[1]); w.y = pk2(kf[2], kf[3]); w.z = pk2(kf[4], kf[5]); w.w = pk2(kf[6], kf[7]);
        *(LAS u32x4*)(lds + L_KS + kl * PK + oc * 16) = w;
#pragma unroll
        for (int e = 0; e < 8; ++e) *(LAS bf16_t*)(lds + L_VT + (oc * 8 + e) * PV + (kl ^ (oc << 2)) * 2) = f2bf(vf[e]);
    }
    LAS float* bt = (LAS float*)(lds + L_BT);
    for (int idx = tid; idx < 1024; idx += 512) { const int g = idx >> 8, ri = idx & 255; const int rel = ri - 191;
        int n = -rel; int ret = n < 0 ? 16 : 0; n = n < 0 ? -n : n;
        int bk;
        if (n < 8) bk = n; else if (n < 12) bk = 8; else if (n < 16) bk = 9; else if (n < 23) bk = 10; else if (n < 32) bk = 11; else if (n < 46) bk = 12; else if (n < 64) bk = 13; else if (n < 91) bk = 14; else bk = 15;
        bt[idx] = a.in[8][(ret + bk) * NQH + kvh * 4 + g] * 1.4426950408889634f; }
    __syncthreads();
    const int g = wave >> 1, hq = kvh * 4 + g;
    const float sink = a.in[22][layer * NQH + hq] * 1.4426950408889634f;
    const float* qng = a.in[20] + layer * 64;
    const int kmin = is_sample ? 0 : (2 - c) * 64;
#pragma unroll 1
    for (int sub = 0; sub < 2; ++sub) {
        const int ql = (wave & 1) * 32 + sub * 16 + fr;
        bf16_t* qp = proj + (size_t)(row0 + ql) * PN + C_Q + hq * 64;
        bf16x8 qf[2];
        {
            float qv[2][8]; float ss = 0.f;
#pragma unroll
            for (int ks = 0; ks < 2; ++ks) { const u32x4 w = sub ? qraw[1][ks] : qraw[0][ks];
                qv[ks][0] = bflo(w.x); qv[ks][1] = bfhi(w.x); qv[ks][2] = bflo(w.y); qv[ks][3] = bfhi(w.y); qv[ks][4] = bflo(w.z); qv[ks][5] = bfhi(w.z); qv[ks][6] = bflo(w.w); qv[ks][7] = bfhi(w.w);
#pragma unroll
                for (int e = 0; e < 8; ++e) ss += qv[ks][e] * qv[ks][e]; }
            ss += __shfl_xor(ss, 16); ss += __shfl_xor(ss, 32);
            const float rs = rsqrtf(ss * (1.f / 64.f) + EPS) * (0.125f * 1.4426950408889634f);
#pragma unroll
            for (int ks = 0; ks < 2; ++ks) { const f32x4 g0 = *(const f32x4*)(qng + 32 * ks + 8 * fq), g1 = *(const f32x4*)(qng + 32 * ks + 8 * fq + 4);
                u32x4 w; w.x = pk2(qv[ks][0] * rs * g0[0], qv[ks][1] * rs * g0[1]); w.y = pk2(qv[ks][2] * rs * g0[2], qv[ks][3] * rs * g0[3]);
                w.z = pk2(qv[ks][4] * rs * g1[0], qv[ks][5] * rs * g1[1]); w.w = pk2(qv[ks][6] * rs * g1[2], qv[ks][7] * rs * g1[3]);
                qf[ks] = __builtin_bit_cast(bf16x8, w); }
        }
        f32x4 sacc[12];
#pragma unroll
        for (int kb = 0; kb < 12; ++kb) { sacc[kb] = (f32x4){0.f, 0.f, 0.f, 0.f};
#pragma unroll
            for (int ks = 0; ks < 2; ++ks) { const bf16x8 av = *(const LAS bf16x8*)(lds + L_KS + (16 * kb + fr) * PK + (32 * ks + 8 * fq) * 2); sacc[kb] = mfma16(av, qf[ks], sacc[kb]); } }
        float mx = sink;
#pragma unroll
        for (int kb = 0; kb < 12; ++kb)
#pragma unroll
            for (int j = 0; j < 4; ++j) { const int kl = 16 * kb + 4 * fq + j;
                const float s = sacc[kb][j] + bt[g * 256 + kl - 128 - ql + 191];
                sacc[kb][j] = s; mx = fmaxf(mx, s); }
        if (kmin > 0) {
            mx = sink;
#pragma unroll
            for (int kb = 0; kb < 12; ++kb)
#pragma unroll
                for (int j = 0; j < 4; ++j) { const int kl = 16 * kb + 4 * fq + j; if (kl < kmin) sacc[kb][j] = -INFINITY; mx = fmaxf(mx, sacc[kb][j]); }
        }
        mx = fmaxf(mx, __shfl_xor(mx, 16)); mx = fmaxf(mx, __shfl_xor(mx, 32));
        float sum = 0.f;
#pragma unroll
        for (int kb = 0; kb < 12; ++kb)
#pragma unroll
            for (int j = 0; j < 4; ++j) { const float p = __builtin_amdgcn_exp2f(sacc[kb][j] - mx); sacc[kb][j] = p; sum += p; }
        sum += __shfl_xor(sum, 16); sum += __shfl_xor(sum, 32);
        const float inv = __builtin_amdgcn_rcpf(sum + __builtin_amdgcn_exp2f(sink - mx));
        f32x4 oacc[4];
#pragma unroll
        for (int db = 0; db < 4; ++db) oacc[db] = (f32x4){0.f, 0.f, 0.f, 0.f};
#pragma unroll
        for (int ks = 0; ks < 6; ++ks) {
            u32x4 pw; pw.x = pk2(sacc[2 * ks][0], sacc[2 * ks][1]); pw.y = pk2(sacc[2 * ks][2], sacc[2 * ks][3]); pw.z = pk2(sacc[2 * ks + 1][0], sacc[2 * ks + 1][1]); pw.w = pk2(sacc[2 * ks + 1][2], sacc[2 * ks + 1][3]);
            const bf16x8 pbv = __builtin_bit_cast(bf16x8, pw);
#pragma unroll
            for (int db = 0; db < 4; ++db) { const LAS unsigned char* vr = lds + L_VT + (16 * db + fr) * PV; const int vkey = ((2 * db + (fr >> 3)) & 7) << 2;
                const u32x2 lo = *(const LAS u32x2*)(vr + ((32 * ks + 4 * fq) ^ vkey) * 2), hi = *(const LAS u32x2*)(vr + ((32 * ks + 16 + 4 * fq) ^ vkey) * 2);
                u32x4 vw; vw.x = lo.x; vw.y = lo.y; vw.z = hi.x; vw.w = hi.y;
                oacc[db] = mfma16(__builtin_bit_cast(bf16x8, vw), pbv, oacc[db]); }
        }
#pragma unroll
        for (int db = 0; db < 4; ++db) { u32x2 w; w.x = pk2(oacc[db][0] * inv, oacc[db][1] * inv); w.y = pk2(oacc[db][2] * inv, oacc[db][3] * inv);
            *(u32x2*)(qp + 16 * db + 4 * fq) = w; }
    }
    __syncthreads();
}

#define XB_TMO      128
#define XB_XCNT(j)  (256  + 64 * (j))
#define XB_XSUB(j)  (1280 + 64 * (j))
#define XB_XGEN(j)  (2304 + 64 * (j))
#define XB_TOP      3328
#define XB_TOPGEN   3392
#define XCD_BAR_WORDS 3456
#define XB_SPIN_CAP (1u << 22)
__device__ __forceinline__ unsigned xb_ld(unsigned* p)              { return __hip_atomic_load(p, __ATOMIC_RELAXED, __HIP_MEMORY_SCOPE_AGENT); }
__device__ __forceinline__ unsigned xb_add(unsigned* p, unsigned v) { return __hip_atomic_fetch_add(p, v, __ATOMIC_RELAXED, __HIP_MEMORY_SCOPE_AGENT); }
__device__ __forceinline__ unsigned xb_xcc_id() { return (unsigned)__builtin_amdgcn_s_getreg((3 << 11) | 20) & 0xFu; }
#define XB_SPIN(cond, bar) do { unsigned _sp = 0; while (cond) { __builtin_amdgcn_s_sleep(1); \
    if ((++_sp & 255u) == 0u) { if (xb_ld(&(bar)[XB_TMO])) break; if (_sp > XB_SPIN_CAP) { atomicAdd(&(bar)[XB_TMO], 1u); break; } } } } while (0)
struct XcdBarrier { unsigned* bar; unsigned x; volatile LAS unsigned* st; };
__device__ __forceinline__ XcdBarrier xcd_barrier_post(unsigned* bar, volatile LAS unsigned* st) {
    XcdBarrier b; b.bar = bar; b.x = xb_xcc_id(); b.st = st;
    if (threadIdx.x == 0) (void)xb_add(&bar[XB_XCNT(b.x)], 1u);
    return b;
}
__device__ __forceinline__ void xcd_barrier_complete(unsigned* bar, unsigned x, unsigned& nloc, unsigned& nx) {
    const unsigned G = gridDim.x * gridDim.y * gridDim.z;
    unsigned sum, cnt, mine, sp = 0u;
    for (;;) {
        sum = 0u; cnt = 0u; mine = 0u;
#pragma unroll
        for (unsigned j = 0; j < 16; ++j) { const unsigned c = xb_ld(&bar[XB_XCNT(j)]); sum += c; cnt += (c > 0u) ? 1u : 0u; mine = (j == x) ? c : mine; }
        if (sum == G) break;
        __builtin_amdgcn_s_sleep(1);
        if ((++sp & 255u) == 0u) { if (xb_ld(&bar[XB_TMO])) break; if (sp > XB_SPIN_CAP) { atomicAdd(&bar[XB_TMO], 1u); break; } }
    }
    nloc = mine > 0u ? mine : 1u; nx = cnt > 0u ? cnt : 1u;
}
__device__ __forceinline__ void xcd_barrier(const XcdBarrier& b) {
    asm volatile("s_waitcnt vmcnt(0)" ::: "memory");
    __syncthreads();
    if (threadIdx.x == 0) {
        unsigned* bar = b.bar;
        __builtin_amdgcn_s_waitcnt(0);
        unsigned nloc = b.st[0], nx = b.st[1];
        if (nloc == 0u) { xcd_barrier_complete(bar, b.x, nloc, nx); b.st[0] = nloc; b.st[1] = nx; }
        const unsigned old = xb_add(&bar[XB_XSUB(b.x)], 1u);
        const unsigned gen = old / nloc;
        if (old + 1u == (gen + 1u) * nloc) {
            __builtin_amdgcn_fence(__ATOMIC_RELEASE, "agent");
            asm volatile("s_waitcnt vmcnt(0)" ::: "memory");
            const unsigned og = xb_add(&bar[XB_TOP], 1u);
            const unsigned tg = og / nx;
            if (og + 1u == (tg + 1u) * nx) xb_add(&bar[XB_TOPGEN], 1u);
            else XB_SPIN(xb_ld(&bar[XB_TOPGEN]) == tg, bar);
            __builtin_amdgcn_fence(__ATOMIC_ACQUIRE, "agent");
            xb_add(&bar[XB_XGEN(b.x)], 1u);
            asm volatile("s_waitcnt vmcnt(0)" ::: "memory");
        } else {
            XB_SPIN(xb_ld(&bar[XB_XGEN(b.x)]) == gen, bar);
            __builtin_amdgcn_fence(__ATOMIC_ACQUIRE, "agent");
            asm volatile("s_waitcnt vmcnt(0)" ::: "memory");
        }
    }
    __syncthreads();
}

#define OPAQUE_TID() int tq = threadIdx.x; asm volatile("" : "+v"(tq))
__global__ void __launch_bounds__(512, 2) mega_fwd(Args a) {
    extern __shared__ __attribute__((aligned(16))) unsigned char lds_raw[];
    LAS unsigned char* lds = (LAS unsigned char*)lds_raw;
    cg::grid_group grid = cg::this_grid();
    const int tid = threadIdx.x, lane = tid & 63, wave = __builtin_amdgcn_readfirstlane(tid >> 6);
    const int G = gridDim.x, bx = blockIdx.x, gw = bx * 8 + wave, NGW = G * 8;
    bf16_t* Hb = (bf16_t*)(a.ws + WS_H); bf16_t* proj = (bf16_t*)(a.ws + WS_PROJ); float* ssq = (float*)(a.ws + WS_SSQ);
    const float* modall = (const float*)(a.ws + WS_MOD);

    for (int w = bx * 512 + tid; w < XCD_BAR_WORDS; w += G * 512) __hip_atomic_store((unsigned*)(a.ws + WS_CTL) + w, 0u, __ATOMIC_RELAXED, __HIP_MEMORY_SCOPE_AGENT);
    prologue_weights(a, lds, gw, NGW, wave, lane);
    for (int it = bx; it < 192; it += G) prologue_mod_item(a, lds, it, tid);
    volatile LAS unsigned* bst = (volatile LAS unsigned*)(lds + LDS_BYTES - 64);
    if (tid < 2) bst[tid] = 0u;
    __syncthreads();
    grid.sync();
    XcdBarrier xbar = xcd_barrier_post((unsigned*)(a.ws + WS_CTL), bst);

#pragma unroll 1
    for (int layer = 0; layer < 2; ++layer) {
#pragma unroll 1
        for (int slab = 0; slab < 2; ++slab) {
            const int row_base = slab * SLAB0_ROWS, nrows = slab == 0 ? SLAB0_ROWS : SLAB1_ROWS, nMt = nrows / 256;
            const unsigned char* wl = a.ws + (size_t)layer * W_LAYER;
            const float* mod = modall + (size_t)layer * NSEQ * (6 * DM);
            const float* xin_p = layer == 0 ? a.in[0] : a.out + O_Y;
            const float* xin_s = layer == 0 ? a.in[1] : a.out + O_Y + (size_t)MP * DM;
            { OPAQUE_TID(); norm_mod_rows(xin_p, xin_s, a.in[11] + layer * DM, mod, 0, 1, Hb, row_base, nrows, gw, NGW, tq & 63); }
            xcd_barrier(xbar);
            { pg8::Gemm g; g.A0 = g.A1 = g.A2 = Hb; g.B0 = g.B1 = g.B2 = (const bf16_t*)(wl + W_IN); g.K0 = g.K1 = g.K2 = DM; g.lda = DM; g.ldb = DM;
              pg8::StaticOrder S; S.init(nMt, PN / 256, G, bx, 1); EpiProj E{proj, PN};
              OPAQUE_TID(); pg8::gemm_phase<EpiProj>(lds, g, S, E, tq); }
            xcd_barrier(xbar);
            {
                const int nCp = 8 * 32, nCs = slab == 0 ? 0 : NSB * 8;
                for (int L = bx; L < nCp + nCs; L += G) {
                    OPAQUE_TID();
                    if (L < nCp) { const int b = slab * 8 + (L >> 5); convbc_item(a, layer, false, b, L & 31, b * SEQ - row_base, proj, tq); }
                    else { const int r = L - nCp, b = r >> 3; convbc_item(a, layer, true, b, r & 7, MP + b * DSEQ - row_base, proj, tq); }
                    __syncthreads();
                }
            }
            xcd_barrier(xbar);
            {
                const int npseq = 8, nsseq = slab == 0 ? 0 : NSB;
                OPAQUE_TID();
                for (int idx = bx * 512 + tq; idx < (npseq + nsseq) * 3 * DIN; idx += G * 512) {
                    const int sq = idx / (3 * DIN), rem = idx - sq * (3 * DIN), r = rem / DIN, chn = rem - r * DIN;
                    if (sq < npseq) { const int b = slab * 8 + sq; const int lrow = b * SEQ - row_base + (SEQ - 3 + r);
                        a.out[O_CONVP + ((size_t)(layer * NPB + b) * 3 + r) * CONVC + chn] = bf2f(proj[(size_t)lrow * PN + C_XBC + chn]); }
                    else { const int b = sq - npseq; const int lrow = MP + b * DSEQ - row_base + (DSEQ - 3 + r);
                        a.out[O_CONVS + ((size_t)(layer * NSB + b) * 3 + r) * CONVC + chn] = bf2f(proj[(size_t)lrow * PN + C_XBC + chn]); }
                }
                const int nP = 8 * NH, nS = slab == 0 ? 0 : NSB * NH, nAp = 8 * 32 * NKVH, nAs = slab == 0 ? 0 : NSB * NKVH;
                const int total = nP + nS + nAp + nAs;
                for (int L = bx; L < total; L += G) {
                    int r = L;
                    if (r < nP) { const int b = slab * 8 + r / NH, h = r % NH; OPAQUE_TID(); ssd_item(a, lds, layer, false, b, h, b * SEQ - row_base, 32, proj, ssq, tq); continue; } r -= nP;
                    if (r < nS) { const int b = r / NH, h = r % NH; OPAQUE_TID(); ssd_item(a, lds, layer, true, b, h, MP + b * DSEQ - row_base, 1, proj, ssq, tq); continue; } r -= nS;
                    if (r < nAp) { const int kvh = r & 3, c = (r >> 2) & 31, b = slab * 8 + (r >> 7); OPAQUE_TID(); attn_item(a, lds, layer, false, b, c, kvh, b * SEQ - row_base, 32, proj, tq); continue; } r -= nAp;
                    { const int kvh = r & 3, b = r >> 2; OPAQUE_TID(); attn_item(a, lds, layer, true, b, 0, kvh, MP + b * DSEQ - row_base, 1, proj, tq); }
                }
            }
            xcd_barrier(xbar);
            { pg8::Gemm g; g.A0 = proj + C_Z; g.A1 = g.A2 = proj + C_Q; g.B0 = (const bf16_t*)(wl + W_BR); g.B1 = g.B2 = (const bf16_t*)(wl + W_BR) + 2048; g.K0 = DIN; g.K1 = g.K2 = DM; g.lda = PN; g.ldb = 3072;
              pg8::StaticOrder S; S.init(nMt, 4, G, bx, 2); EpiBr E{proj, Hb};
              OPAQUE_TID();
              {
                  Unit u; const int k = tq >> 8, row = tq & 255;
                  if (S.next(2 * k, u)) {
                      const f32x4* q = (const f32x4*)(ssq + (size_t)(u.pm * 256 + row) * NH);
                      float r[4];
#pragma unroll
                      for (int gq = 0; gq < 4; ++gq) { const f32x4 x0 = q[2 * gq], x1 = q[2 * gq + 1]; r[gq] = rsqrtf(((x0[0] + x0[1]) + (x0[2] + x0[3]) + (x1[0] + x1[1]) + (x1[2] + x1[3])) * (1.f / 512.f) + EPS); }
                      *(LAS f32x4*)(lds + pg8::STAGE_BYTES + (k * 256 + row) * 16) = (f32x4){r[0] / r[1], r[1] / r[2], r[2] / r[3], r[3]};
                  }
                  __syncthreads();
              }
              pg8::gemm_phase<EpiBr, true>(lds, g, S, E, tq); }
            xcd_barrier(xbar);
            { pg8::Gemm g; g.A0 = g.A1 = g.A2 = Hb; g.B0 = g.B1 = g.B2 = (const bf16_t*)(wl + W_O); g.K0 = g.K1 = g.K2 = DM; g.lda = DM; g.ldb = DM;
              pg8::StaticOrder S; S.init(nMt, 4, G, bx, 1); EpiRes E{xin_p, xin_s, a.out + O_Y, mod + 2 * DM, row_base};
              OPAQUE_TID(); pg8::gemm_phase<EpiRes>(lds, g, S, E, tq); }
            xcd_barrier(xbar);
        }
        {
            const unsigned char* wl = a.ws + (size_t)layer * W_LAYER;
            const float* mod = modall + (size_t)layer * NSEQ * (6 * DM);
            { OPAQUE_TID(); norm_mod_rows(a.out + O_Y, a.out + O_Y + (size_t)MP * DM, a.in[12] + layer * DM, mod, 3, 4, Hb, 0, MTOT, gw, NGW, tq & 63); }
            xcd_barrier(xbar);
            { pg8::Gemm g; g.A0 = g.A1 = g.A2 = Hb; g.B0 = g.B1 = g.B2 = (const bf16_t*)(wl + W_GU); g.K0 = g.K1 = g.K2 = DM; g.lda = DM; g.ldb = DM;
              pg8::StaticOrder S; S.init(MTOT / 256, 2 * DFF / 256, G, bx, 1); EpiSwiglu E{proj};
              OPAQUE_TID(); pg8::gemm_phase<EpiSwiglu>(lds, g, S, E, tq); }
            xcd_barrier(xbar);
            { pg8::Gemm g; g.A0 = g.A1 = proj; g.A2 = proj + DFF / 2; g.B0 = g.B1 = (const bf16_t*)(wl + W_D); g.B2 = (const bf16_t*)(wl + W_D) + DFF / 2; g.K0 = DFF; g.K1 = g.K2 = DFF / 2; g.lda = DFF; g.ldb = DFF;
              pg8::StaticOrder S; S.init(MTOT / 256, 4, G, bx, 1, false);    EpiRes E{a.out + O_Y, a.out + O_Y + (size_t)MP * DM, a.out + O_Y, mod + 5 * DM, 0};
              OPAQUE_TID(); pg8::gemm_phase<EpiRes>(lds, g, S, E, tq); }
            if (layer == 0) xcd_barrier(xbar);
        }
    }
}

extern "C" void kernel_launch(void* const* d_in, const int* in_sizes, int n_in, void* d_out, int out_size, void* d_ws, size_t ws_size, hipStream_t stream) {
    static int grid = 0;
    if (grid == 0) {
        if (n_in != 28 || ws_size < WS_END) { fprintf(stderr, "kernel_launch: need 28 inputs and %zu bytes of workspace (got %d, %zu)\n", (size_t)WS_END, n_in, ws_size); grid = -1; return; }
        int dev = 0, cus = 0, per_cu = 0;
        hipGetDevice(&dev);
        hipDeviceGetAttribute(&cus, hipDeviceAttributeMultiprocessorCount, dev);
        hipFuncSetAttribute((const void*)mega_fwd, hipFuncAttributeMaxDynamicSharedMemorySize, LDS_BYTES);
        hipOccupancyMaxActiveBlocksPerMultiprocessor(&per_cu, (const void*)mega_fwd, 512, LDS_BYTES);
        if (per_cu < 1) per_cu = 1;
        grid = cus;
        (void)hipGetLastError();
    }
    if (grid < 0) return;
    Args a{};
    for (int i = 0; i < 28; ++i) a.in[i] = (const float*)d_in[i];
    a.out = (float*)d_out; a.ws = (unsigned char*)d_ws;
    void* args[] = {&a};
    hipError_t e = hipLaunchCooperativeKernel((const void*)mega_fwd, dim3(grid), dim3(512), args, LDS_BYTES, stream);
    if (e != hipSuccess) fprintf(stderr, "cooperative launch failed: %s (grid %d)\n", hipGetErrorString(e), grid);
}
```

```cpp
#include <hip/hip_runtime.h>
#include <hip/hip_cooperative_groups.h>
#include <cstdio>
#include <cstdint>
namespace cg = cooperative_groups;

#define LAS __attribute__((address_space(3)))
typedef unsigned short bf16_t;
typedef short bf16x8 __attribute__((ext_vector_type(8)));
typedef short s16x4 __attribute__((ext_vector_type(4)));
typedef float f32x4 __attribute__((ext_vector_type(4)));
typedef unsigned u32x4 __attribute__((ext_vector_type(4)));
typedef unsigned u32x2 __attribute__((ext_vector_type(2)));
typedef float f32x2 __attribute__((ext_vector_type(2)));

constexpr int DM = 1024, NPB = 16, SEQ = 2048, NSB = 32, DSEQ = 64, MP = NPB * SEQ, MS = NSB * DSEQ, MTOT = MP + MS;
constexpr int DIN = 2048, CONVC = 3072, NH = 32, DSTATE = 128, NQH = 16, NKVH = 4, DFF = 2816, INCOLS = 8736;
constexpr int PN = 8960;
constexpr int C_Z = 0, C_XBC = 2048, C_Q = 5120, C_K = 6144, C_V = 6400, C_GS = 6656, C_GA = 7680, C_DT = 8704;
constexpr int NSEQ = NPB + NSB;
constexpr float EPS = 1e-6f;
constexpr int SLAB0_ROWS = 16384, SLAB1_ROWS = MTOT - SLAB0_ROWS;
constexpr int SLAB_MAXROWS = SLAB1_ROWS;

constexpr size_t O_Y = 0, O_CONVP = 35651584, O_CONVS = 35946496, O_SSMP = 36536320, O_SSMS = 44924928,
                 O_KP = 61702144, O_KS = 62750720, O_VP = 63799296, O_VS = 64847872;

constexpr size_t W_IN = 0, W_BR = 18350080, W_O = 24641536, W_GU = 26738688, W_D = 38273024, W_LAYER = 44040192;
constexpr size_t WS_MOD = 2 * W_LAYER, WS_SSQ = WS_MOD + 2359296, WS_H = WS_SSQ + 2359296, WS_PROJ = WS_H + (size_t)MTOT * DM * 2,
                 WS_CTL = WS_PROJ + (size_t)SLAB_MAXROWS * PN * 2, WS_END = WS_CTL + 16384;

constexpr int LDS_BYTES = 140 * 1024;

__device__ __forceinline__ unsigned pk2(float lo, float hi) { unsigned r; asm("v_cvt_pk_bf16_f32 %0, %1, %2" : "=v"(r) : "v"(lo), "v"(hi)); return r; }
__device__ __forceinline__ bf16_t f2bf(float f) { return (bf16_t)(pk2(f, 0.f) & 0xffffu); }
__device__ __forceinline__ float bflo(unsigned w) { return __uint_as_float(w << 16); }
__device__ __forceinline__ float bfhi(unsigned w) { return __uint_as_float(w & 0xffff0000u); }
__device__ __forceinline__ float bf2f(bf16_t h) { return __uint_as_float(((unsigned)h) << 16); }
__device__ __forceinline__ float sigmoidf_(float x) { return __builtin_amdgcn_rcpf(1.f + __expf(-x)); }
__device__ __forceinline__ float siluf_(float x) { return x * __builtin_amdgcn_rcpf(1.f + __expf(-x)); }
__device__ __forceinline__ float row16_sum(float v) {
    v += __builtin_bit_cast(float, __builtin_amdgcn_update_dpp(0, __builtin_bit_cast(int, v), 0xB1, 0xF, 0xF, true));
    v += __builtin_bit_cast(float, __builtin_amdgcn_update_dpp(0, __builtin_bit_cast(int, v), 0x4E, 0xF, 0xF, true));
    v += __builtin_bit_cast(float, __builtin_amdgcn_update_dpp(0, __builtin_bit_cast(int, v), 0x141, 0xF, 0xF, true));
    v += __builtin_bit_cast(float, __builtin_amdgcn_update_dpp(0, __builtin_bit_cast(int, v), 0x140, 0xF, 0xF, true));
    return v;
}
__device__ __forceinline__ f32x4 mfma16(bf16x8 a, bf16x8 b, f32x4 c) { return __builtin_amdgcn_mfma_f32_16x16x32_bf16(a, b, c, 0, 0, 0); }
#define LDS_WAIT() asm volatile("s_waitcnt lgkmcnt(0)" ::: "memory")
#define LBAR() do { asm volatile("s_waitcnt lgkmcnt(0)" ::: "memory"); __builtin_amdgcn_s_barrier(); asm volatile("" ::: "memory"); } while (0)

namespace pg8 {
constexpr int BM = 256, BK = 64, HALF = 128, HTB = HALF * BK * 2, STAGE_BYTES = 8 * HTB, NXCD = 8, WGM = 8;
__host__ __device__ __forceinline__ int lds_byte(int r, int c) { const int st = (r >> 4) * 2 + (c >> 5), rr = r & 15, cc = c & 31, ob = rr * 64 + cc * 2; return st * 1024 + (ob ^ (((ob >> 9) & 1) << 5)); }
__host__ __device__ __forceinline__ void stage_rc(int b, int& R, int& C) { const int st = b / 1024, sb = b % 1024, swz = sb ^ (((sb >> 9) & 1) << 5); R = (st >> 1) * 16 + swz / 64; C = (st & 1) * 32 + (swz % 64) / 2; }
__host__ __device__ __forceinline__ int perm32(int rho) { const int n = rho >> 4, i = rho & 15; return 8 * (i >> 2) + 4 * n + (i & 3); }

struct Unit { int pm, pn, part; };
struct Gemm { const bf16_t* A0; const bf16_t* A1; const bf16_t* A2; const bf16_t* B0; const bf16_t* B1; const bf16_t* B2; int K0, K1, K2; int lda, ldb;
    __device__ __forceinline__ const char* Ap(int part) const { return (const char*)A0 + (long)(part == 1) * ((const char*)A1 - (const char*)A0) + (long)(part == 2) * ((const char*)A2 - (const char*)A0); }
    __device__ __forceinline__ const char* Bp(int part) const { return (const char*)B0 + (long)(part == 1) * ((const char*)B1 - (const char*)B0) + (long)(part == 2) * ((const char*)B2 - (const char*)B0); }
    __device__ __forceinline__ int Kp(int part) const { return K0 + (part == 1) * (K1 - K0) + (part == 2) * (K2 - K0); } };

struct StaticOrder {
    int nM, nN, nwg, G, c, np, split_from;
    __device__ __forceinline__ void init(int nM_, int nN_, int G_, int c_, int np_, bool split_tail = false) { nM = nM_; nN = nN_; nwg = nM * nN; G = G_; c = c_; np = np_; split_from = split_tail ? (nwg / G) * G : nwg; }
    __device__ __forceinline__ bool next(int i, Unit& u) const {
        const int r = i / np; u.part = i - r * np;
        long L = (long)r * G + c;
        if (L >= split_from) { const long Ls = L - split_from; if (Ls >= 2L * (nwg - split_from)) return false; L = split_from + (Ls >> 1); u.part = 1 + (int)(Ls & 1); }
        if (L >= nwg) return false;
        int wgid = (int)L; { const int q = nwg / NXCD, rr = nwg % NXCD, xcd = wgid % NXCD, off = wgid / NXCD; wgid = (xcd < rr ? xcd * (q + 1) : rr * (q + 1) + (xcd - rr) * q) + off; }
        const int nig = WGM * nN, gid = wgid / nig, fm = gid * WGM, gsz = (nM - fm) < WGM ? (nM - fm) : WGM;
        u.pm = fm + ((wgid % nig) % gsz); u.pn = (wgid % nig) / gsz; return true;
    }
};

template <class Epi, bool GS = false>
__device__ __forceinline__ void gemm_phase(LAS unsigned char* lds, const Gemm g, const StaticOrder& S, const Epi& E, const int tid) {
    const int wid = __builtin_amdgcn_readfirstlane(tid >> 6), lane = tid & 63, wr = wid >> 2, wc = wid & 3, fr = lane & 15, fq = lane >> 4;
    unsigned voffA[2], voffB[2];
#pragma unroll
    for (int i = 0; i < 2; ++i) { int R, C; stage_rc(tid * 16 + i * 8192, R, C); const int Rb = Epi::PERM ? ((R & ~31) + perm32(R & 31)) : R;
        voffA[i] = (unsigned)(R * g.lda + C) * 2u; voffB[i] = (unsigned)(Rb * g.ldb + C) * 2u; }
    const size_t kstep = (size_t)(BK * 2);
    const size_t hstepA = (size_t)HALF * g.lda * 2, hstepB = (size_t)HALF * g.ldb * 2;
    const size_t tstepA = 2 * hstepA, tstepB = 2 * hstepB;
    const unsigned ldsw = (unsigned)wid * 1024u;
    const int aoff = lds_byte(wr * 64 + fr, fq * 8), boff = lds_byte(wc * 32 + fr, fq * 8);
#define PG8_SA(b, h) (((b) * 2 + (h)) * HTB)
#define PG8_SB(b, h) ((4 + (b) * 2 + (h)) * HTB)
#define PG8_STAGE(bufoff, gbase, voff) do { _Pragma("unroll") for (int _i = 0; _i < 2; ++_i) \
        __builtin_amdgcn_global_load_lds((const unsigned*)((const char*)(gbase) + (voff)[_i]), (LAS unsigned*)(lds + (bufoff) + ldsw + _i * 8192), 16, 0, 0); } while (0)
#define PG8_LDA(dst, b, h) do { _Pragma("unroll") for (int m = 0; m < 4; ++m) _Pragma("unroll") for (int k = 0; k < 2; ++k) dst[m][k] = *(const LAS bf16x8*)(lds + PG8_SA(b, h) + aoff + m * 2048 + k * 1024); } while (0)
#define PG8_LDB(dst, b, h) do { _Pragma("unroll") for (int n = 0; n < 2; ++n) _Pragma("unroll") for (int k = 0; k < 2; ++k) dst[n][k] = *(const LAS bf16x8*)(lds + PG8_SB(b, h) + boff + n * 2048 + k * 1024); } while (0)
#define PG8_MMA(ai, bj, At, Bt) do { __builtin_amdgcn_s_setprio(1); _Pragma("unroll") for (int m = 0; m < 4; ++m) _Pragma("unroll") for (int n = 0; n < 2; ++n) _Pragma("unroll") for (int k = 0; k < 2; ++k) \
        acc[ai][bj][m][n] = __builtin_amdgcn_mfma_f32_16x16x32_bf16(Bt[n][k], At[m][k], acc[ai][bj][m][n], 0, 0, 0); __builtin_amdgcn_s_setprio(0); } while (0)
#define PG8_WAIT_V(n) asm volatile("s_waitcnt vmcnt(" #n ")" ::: "memory")
#define PG8_WAIT_L(n) asm volatile("s_waitcnt lgkmcnt(" #n ")" ::: "memory")
#define PG8_BAR __builtin_amdgcn_s_barrier()
#define PG8_SCHED __builtin_amdgcn_sched_barrier(0)
    Unit cur, nxt; int ui = 0;
    if (!S.next(0, cur)) return;
    f32x4 acc[2][2][4][2];
#pragma unroll
    for (int a = 0; a < 2; ++a)
#pragma unroll
        for (int b = 0; b < 2; ++b)
#pragma unroll
            for (int m = 0; m < 4; ++m)
#pragma unroll
                for (int n = 0; n < 2; ++n) acc[a][b][m][n] = (f32x4){0.f, 0.f, 0.f, 0.f};
    bf16x8 At[4][2], B0[2][2], B1[2][2];
    const char* cA = g.Ap(cur.part) + (size_t)cur.pm * tstepA; const char* cB = g.Bp(cur.part) + (size_t)cur.pn * tstepB;
    PG8_STAGE(PG8_SB(0, 0), cB, voffB); PG8_STAGE(PG8_SB(0, 1), cB + hstepB, voffB); PG8_STAGE(PG8_SA(0, 0), cA, voffA); PG8_STAGE(PG8_SA(0, 1), cA + hstepA, voffA);
    if (wr == 1) PG8_BAR;
    PG8_WAIT_V(2); PG8_BAR;
    PG8_STAGE(PG8_SB(1, 0), cB + kstep, voffB); PG8_STAGE(PG8_SA(1, 0), cA + kstep, voffA); PG8_STAGE(PG8_SB(1, 1), cB + hstepB + kstep, voffB);
    PG8_WAIT_V(6); PG8_BAR;
    for (;;) {
        const bool has_next = S.next(ui + 1, nxt);
        const char* nA = has_next ? g.Ap(nxt.part) + (size_t)nxt.pm * tstepA : cA; const char* nB = has_next ? g.Bp(nxt.part) + (size_t)nxt.pn * tstepB : cB;
        const int nt = g.Kp(cur.part) / BK;
        const int seg = (GS && cur.part == 0) ? 8 : nt;
        for (int tg = 0; tg < nt; tg += seg) {
        for (int t = tg; t < tg + seg; t += 2) {
            const bool last = (t == nt - 2);
            const char* a1 = cA + (size_t)(t + 1) * kstep;
            const char* a2 = last ? nA : cA + (size_t)(t + 2) * kstep; const char* b2 = last ? nB : cB + (size_t)(t + 2) * kstep;
            const char* a3 = a2 + kstep; const char* b3 = b2 + kstep;
            PG8_LDB(B0, 0, 0); PG8_LDB(B1, 0, 1); PG8_SCHED; PG8_LDA(At, 0, 0); PG8_STAGE(PG8_SA(1, 1), a1 + hstepA, voffA);
            PG8_WAIT_V(8); PG8_WAIT_L(0); PG8_BAR; PG8_MMA(0, 0, At, B0); PG8_MMA(0, 1, At, B1); PG8_BAR; PG8_SCHED;
            PG8_LDA(At, 0, 1); PG8_STAGE(PG8_SB(0, 0), b2, voffB); PG8_STAGE(PG8_SB(0, 1), b2 + hstepB, voffB); PG8_STAGE(PG8_SA(0, 0), a2, voffA);
            PG8_WAIT_V(8); PG8_WAIT_L(0); PG8_BAR; PG8_MMA(1, 0, At, B0); PG8_MMA(1, 1, At, B1); PG8_BAR; PG8_SCHED;
            PG8_LDB(B0, 1, 0); PG8_LDB(B1, 1, 1); PG8_SCHED; PG8_LDA(At, 1, 0); PG8_STAGE(PG8_SA(0, 1), a2 + hstepA, voffA);
            PG8_WAIT_V(8); PG8_WAIT_L(0); PG8_BAR; PG8_MMA(0, 0, At, B0); PG8_MMA(0, 1, At, B1); PG8_BAR; PG8_SCHED;
            PG8_LDA(At, 1, 1); PG8_STAGE(PG8_SB(1, 0), b3, voffB); PG8_STAGE(PG8_SB(1, 1), b3 + hstepB, voffB); PG8_STAGE(PG8_SA(1, 0), a3, voffA);
            PG8_WAIT_V(8); PG8_WAIT_L(0); PG8_BAR; PG8_MMA(1, 0, At, B0); PG8_MMA(1, 1, At, B1); PG8_BAR; PG8_SCHED;
        }
        if constexpr (GS) {
            const bool ds = cur.part == 0;
            const LAS float* rt = (const LAS float*)(lds + STAGE_BYTES) + (ui >> 1) * 1024 + (tg >> 3) + (wr * 64 + fr) * 4;
#pragma unroll
            for (int a = 0; a < 2; ++a)
#pragma unroll
                for (int m = 0; m < 4; ++m) { const float f = ds ? rt[(a * HALF + m * 16) * 4] : 1.f;
#pragma unroll
                    for (int b = 0; b < 2; ++b)
#pragma unroll
                        for (int n = 0; n < 2; ++n) acc[a][b][m][n] = acc[a][b][m][n] * f; }
        }
        }
        if (wr == 0) PG8_BAR;
        E(acc, cur, wr, wc, fr, fq);
        if (!has_next) break;
#pragma unroll
        for (int a = 0; a < 2; ++a)
#pragma unroll
            for (int b = 0; b < 2; ++b)
#pragma unroll
                for (int m = 0; m < 4; ++m)
#pragma unroll
                    for (int n = 0; n < 2; ++n) acc[a][b][m][n] = (f32x4){0.f, 0.f, 0.f, 0.f};
        cur = nxt; cA = nA; cB = nB; ++ui;
        if (wr == 1) PG8_BAR;
    }
    PG8_WAIT_V(0);
    PG8_BAR;
#undef PG8_SA
#undef PG8_SB
#undef PG8_STAGE
#undef PG8_LDA
#undef PG8_LDB
#undef PG8_MMA
#undef PG8_WAIT_V
#undef PG8_WAIT_L
#undef PG8_BAR
#undef PG8_SCHED
}
}
using pg8::Unit;
constexpr int HALF = 128, BM = 256;

struct EpiProj {
    static constexpr bool PERM = true;
    bf16_t* O; int ldc;
    __device__ __forceinline__ void operator()(const f32x4 (&acc)[2][2][4][2], const Unit& u, int wr, int wc, int fr, int fq) const {
        const int row0 = u.pm * BM + wr * 64 + fr, col0 = u.pn * BM + wc * 32 + 8 * fq;
#pragma unroll
        for (int ai = 0; ai < 2; ++ai)
#pragma unroll
            for (int m = 0; m < 4; ++m) { bf16_t* rowp = O + (size_t)(row0 + ai * HALF + m * 16) * ldc + col0;
#pragma unroll
                for (int bj = 0; bj < 2; ++bj) { const f32x4 v0 = acc[ai][bj][m][0], v1 = acc[ai][bj][m][1];
                    u32x4 w; w.x = pk2(v0[0], v0[1]); w.y = pk2(v0[2], v0[3]); w.z = pk2(v1[0], v1[1]); w.w = pk2(v1[2], v1[3]);
                    *(u32x4*)(rowp + bj * HALF) = w; } }
    }
};
struct EpiBr {
    static constexpr bool PERM = true;
    const bf16_t* proj; bf16_t* mix;
    __device__ __forceinline__ void operator()(const f32x4 (&acc)[2][2][4][2], const Unit& u, int wr, int wc, int fr, int fq) const {
        const int row0 = u.pm * BM + wr * 64 + fr, col0 = u.pn * BM + wc * 32 + 8 * fq;
        const int gbase = u.part == 0 ? C_GS : C_GA;
#pragma unroll
        for (int ai = 0; ai < 2; ++ai) {
#pragma unroll
            for (int mp = 0; mp < 2; ++mp) {
            u32x4 gw[2][2], pw[2][2];
#pragma unroll
            for (int mm = 0; mm < 2; ++mm) { const int row = row0 + ai * HALF + (2 * mp + mm) * 16;
#pragma unroll
                for (int bj = 0; bj < 2; ++bj) { const int col = col0 + bj * HALF;
                    gw[mm][bj] = *(const u32x4*)(proj + (size_t)row * PN + gbase + col);
                    pw[mm][bj] = u.part == 1 ? *(const u32x4*)(mix + (size_t)row * DM + col) : (u32x4){0u, 0u, 0u, 0u}; } }
#pragma unroll
            for (int mm = 0; mm < 2; ++mm) { const int m = 2 * mp + mm; const int row = row0 + ai * HALF + m * 16;
#pragma unroll
                for (int bj = 0; bj < 2; ++bj) { const int col = col0 + bj * HALF;
                    const u32x4 g = gw[mm][bj], p = pw[mm][bj];
                    const f32x4 v0 = acc[ai][bj][m][0], v1 = acc[ai][bj][m][1];
                    float r[8];
                    r[0] = sigmoidf_(bflo(g.x)) * v0[0] + bflo(p.x); r[1] = sigmoidf_(bfhi(g.x)) * v0[1] + bfhi(p.x); r[2] = sigmoidf_(bflo(g.y)) * v0[2] + bflo(p.y); r[3] = sigmoidf_(bfhi(g.y)) * v0[3] + bfhi(p.y);
                    r[4] = sigmoidf_(bflo(g.z)) * v1[0] + bflo(p.z); r[5] = sigmoidf_(bfhi(g.z)) * v1[1] + bfhi(p.z); r[6] = sigmoidf_(bflo(g.w)) * v1[2] + bflo(p.w); r[7] = sigmoidf_(bfhi(g.w)) * v1[3] + bfhi(p.w);
                    u32x4 w; w.x = pk2(r[0], r[1]); w.y = pk2(r[2], r[3]); w.z = pk2(r[4], r[5]); w.w = pk2(r[6], r[7]);
                    *(u32x4*)(mix + (size_t)row * DM + col) = w; } }
            }
        }
    }
};
struct EpiRes {
    static constexpr bool PERM = false;
    const float* xin_p; const float* xin_s; float* out; const float* gate; int row_base;
    __device__ __forceinline__ void operator()(const f32x4 (&acc)[2][2][4][2], const Unit& u, int wr, int wc, int fr, int fq) const {
        const int col0 = u.pn * BM + wc * 32 + 4 * fq;
#pragma unroll
        for (int ai = 0; ai < 2; ++ai) {
            const int grb = row_base + u.pm * BM + ai * HALF + wr * 64;
            const int seq = grb < MP ? (grb >> 11) : NPB + ((grb - MP) >> 6);
            const float* gp = gate + (size_t)seq * (6 * DM) + col0;
            f32x4 gv[2][2];
#pragma unroll
            for (int bj = 0; bj < 2; ++bj)
#pragma unroll
                for (int n = 0; n < 2; ++n) gv[bj][n] = *(const f32x4*)(gp + bj * HALF + n * 16);
            if (u.part == 0) {
#pragma unroll
                for (int mp = 0; mp < 2; ++mp) {
                f32x4 xv[2][2][2];
#pragma unroll
                for (int mm = 0; mm < 2; ++mm) { const int gr = grb + (2 * mp + mm) * 16 + fr;
                    const float* xr = (gr < MP ? xin_p + (size_t)gr * DM : xin_s + (size_t)(gr - MP) * DM) + col0;
#pragma unroll
                    for (int bj = 0; bj < 2; ++bj)
#pragma unroll
                        for (int n = 0; n < 2; ++n) xv[mm][bj][n] = *(const f32x4*)(xr + bj * HALF + n * 16); }
#pragma unroll
                for (int mm = 0; mm < 2; ++mm) { const int m = 2 * mp + mm; const int gr = grb + m * 16 + fr; float* orow = out + (size_t)gr * DM + col0;
#pragma unroll
                    for (int bj = 0; bj < 2; ++bj)
#pragma unroll
                        for (int n = 0; n < 2; ++n) *(f32x4*)(orow + bj * HALF + n * 16) = xv[mm][bj][n] + gv[bj][n] * acc[ai][bj][m][n]; }
                }
            } else {
#pragma unroll
                for (int m = 0; m < 4; ++m) { const int gr = grb + m * 16 + fr; float* orow = out + (size_t)gr * DM + col0;
#pragma unroll
                    for (int bj = 0; bj < 2; ++bj)
#pragma unroll
                        for (int n = 0; n < 2; ++n) { const f32x4 d = gv[bj][n] * acc[ai][bj][m][n]; float* o = orow + bj * HALF + n * 16;
                            __hip_atomic_fetch_add(o + 0, d[0], __ATOMIC_RELAXED, __HIP_MEMORY_SCOPE_AGENT); __hip_atomic_fetch_add(o + 1, d[1], __ATOMIC_RELAXED, __HIP_MEMORY_SCOPE_AGENT);
                            __hip_atomic_fetch_add(o + 2, d[2], __ATOMIC_RELAXED, __HIP_MEMORY_SCOPE_AGENT); __hip_atomic_fetch_add(o + 3, d[3], __ATOMIC_RELAXED, __HIP_MEMORY_SCOPE_AGENT); } }
            }
        }
    }
};
struct EpiSwiglu {
    static constexpr bool PERM = true;
    bf16_t* act;
    __device__ __forceinline__ void operator()(const f32x4 (&acc)[2][2][4][2], const Unit& u, int wr, int wc, int fr, int fq) const {
        const int row0 = u.pm * BM + wr * 64 + fr, col0 = u.pn * HALF + wc * 32 + 8 * fq;
#pragma unroll
        for (int ai = 0; ai < 2; ++ai)
#pragma unroll
            for (int m = 0; m < 4; ++m) { const int row = row0 + ai * HALF + m * 16;
                const f32x4 g0 = acc[ai][0][m][0], g1 = acc[ai][0][m][1], u0 = acc[ai][1][m][0], u1 = acc[ai][1][m][1];
                u32x4 w; w.x = pk2(siluf_(g0[0]) * u0[0], siluf_(g0[1]) * u0[1]); w.y = pk2(siluf_(g0[2]) * u0[2], siluf_(g0[3]) * u0[3]);
                w.z = pk2(siluf_(g1[0]) * u1[0], siluf_(g1[1]) * u1[1]); w.w = pk2(siluf_(g1[2]) * u1[2], siluf_(g1[3]) * u1[3]);
                *(u32x4*)(act + (size_t)row * DFF + col0) = w; }
    }
};

struct Args { const float* in[28]; float* out; unsigned char* ws; };

__device__ __forceinline__ float wave_sum(float v) {
#pragma unroll
    for (int o = 1; o < 64; o <<= 1) v += __shfl_xor(v, o);
    return v;
}

__device__ __forceinline__ void transpose_item(const float* __restrict__ W, int ldw, int src_c0, int k0, bf16_t* __restrict__ WT, int ldk, int drow0, int dk0, LAS float* scr, int lane, const float* __restrict__ kscale = nullptr) {
    if (src_c0 >= 0) {
#pragma unroll
        for (int i = 0; i < 32; ++i) { const int kk = 2 * i + (lane >> 5); scr[kk * 33 + (lane & 31)] = __builtin_nontemporal_load(&W[(size_t)(k0 + kk) * ldw + src_c0 + (lane & 31)]) * (kscale ? kscale[k0 + kk] : 1.f); }
    } else {
#pragma unroll 8
        for (int i = 0; i < 32; ++i) { const int kk = 2 * i + (lane >> 5); scr[kk * 33 + (lane & 31)] = 0.f; }
    }
    LDS_WAIT(); asm volatile("" ::: "memory");
    const int c = lane & 7;
#pragma unroll
    for (int j = 0; j < 4; ++j) { const int n = (lane >> 3) + 8 * j; const LAS float* s = scr + (8 * c) * 33 + n;
        u32x4 o; o.x = pk2(s[0 * 33], s[1 * 33]); o.y = pk2(s[2 * 33], s[3 * 33]); o.z = pk2(s[4 * 33], s[5 * 33]); o.w = pk2(s[6 * 33], s[7 * 33]);
        *(u32x4*)(WT + (size_t)(drow0 + n) * ldk + dk0 + k0 + 8 * c) = o; }
    LDS_WAIT(); asm volatile("" ::: "memory");
}

__device__ __forceinline__ void prologue_weights(const Args& a, LAS unsigned char* lds, int gw, int NGW, int wave, int lane) {
    LAS float* scr = (LAS float*)(lds + wave * 16384);
    constexpr int I_IN = 16 * (PN / 32), I_BS = 32 * 32, I_BA = 16 * 32, I_O = 16 * 32, I_GU = 16 * (2 * DFF / 32), I_D = (DFF / 64) * 32;
    constexpr int PER_LAYER = I_IN + I_BS + I_BA + I_O + I_GU + I_D;
    for (int it = gw; it < 2 * PER_LAYER; it += NGW) {
        const int l = it / PER_LAYER; int r = it - l * PER_LAYER;
        unsigned char* wl = a.ws + (size_t)l * W_LAYER;
        if (r < I_IN) { const int nblk = PN / 32, kb = r / nblk, nb = r % nblk, n0 = nb * 32;
            const int src = n0 < 5120 ? n0 : (n0 < 8704 ? n0 + 32 : (n0 < 8736 ? 5120 : -1));
            transpose_item(a.in[13] + (size_t)l * DM * INCOLS, INCOLS, src, kb * 64, (bf16_t*)(wl + W_IN), DM, n0, 0, scr, lane); continue; } r -= I_IN;
        if (r < I_BS) { const int kb = r / 32, nb = r % 32;
            transpose_item(a.in[23] + (size_t)l * DIN * DM, DM, nb * 32, kb * 64, (bf16_t*)(wl + W_BR), 3072, nb * 32, 0, scr, lane, a.in[19] + l * DIN); continue; } r -= I_BS;
        if (r < I_BA) { const int kb = r / 32, nb = r % 32;
            transpose_item(a.in[24] + (size_t)l * DM * DM, DM, nb * 32, kb * 64, (bf16_t*)(wl + W_BR), 3072, nb * 32, 2048, scr, lane); continue; } r -= I_BA;
        if (r < I_O) { const int kb = r / 32, nb = r % 32;
            transpose_item(a.in[25] + (size_t)l * DM * DM, DM, nb * 32, kb * 64, (bf16_t*)(wl + W_O), DM, nb * 32, 0, scr, lane); continue; } r -= I_O;
        if (r < I_GU) { const int nblk = 2 * DFF / 32, kb = r / nblk, nb = r % nblk, n0 = nb * 32, j = n0 >> 8, rr = n0 & 255;
            const int src = rr < 128 ? j * 128 + rr : DFF + j * 128 + (rr - 128);
            transpose_item(a.in[26] + (size_t)l * DM * 2 * DFF, 2 * DFF, src, kb * 64, (bf16_t*)(wl + W_GU), DM, n0, 0, scr, lane); continue; } r -= I_GU;
        { const int kb = r / 32, nb = r % 32;
            transpose_item(a.in[27] + (size_t)l * DFF * DM, DM, nb * 32, kb * 64, (bf16_t*)(wl + W_D), DFF, nb * 32, 0, scr, lane); }
    }
}

__device__ __forceinline__ void prologue_mod_item(const Args& a, LAS unsigned char* lds, int item, int tid) {
    const int l = item / 96, n0 = (item % 96) * 64;
    const float* W = a.in[9] + (size_t)l * DM * (6 * DM);
    LAS float* sl = (LAS float*)lds;
    const int col = tid & 63, kp = tid >> 6;
    f32x2 acc[NSEQ / 2];
#pragma unroll
    for (int s = 0; s < NSEQ / 2; ++s) acc[s] = (f32x2){0.f, 0.f};
    for (int half = 0; half < 2; ++half) {
        __syncthreads();
        for (int idx = tid; idx < 512 * NSEQ; idx += 512) { const int s = idx >> 9, kl = idx & 511, k = half * 512 + kl;
            const float v = s < NPB ? a.in[6][s * DM + k] : a.in[7][(s - NPB) * DM + k];
            sl[kl * NSEQ + s] = siluf_(v); }
        __syncthreads();
#pragma unroll 16
        for (int kk = 0; kk < 64; ++kk) { const int kl = kp * 64 + kk;
            const float w = __builtin_nontemporal_load(&W[(size_t)(half * 512 + kl) * (6 * DM) + n0 + col]);
            const LAS f32x4* sp = (const LAS f32x4*)(sl + kl * NSEQ);
#pragma unroll
            for (int q = 0; q < NSEQ / 4; ++q) { const f32x4 sv = sp[q]; const f32x2 w2 = (f32x2){w, w};
                acc[2 * q] = __builtin_elementwise_fma((f32x2){sv[0], sv[1]}, w2, acc[2 * q]); acc[2 * q + 1] = __builtin_elementwise_fma((f32x2){sv[2], sv[3]}, w2, acc[2 * q + 1]); } }
    }
    __syncthreads();
#pragma unroll
    for (int s = 0; s < NSEQ; ++s) sl[(kp * NSEQ + s) * 64 + col] = acc[s >> 1][s & 1];
    __syncthreads();
    float* mod = (float*)(a.ws + WS_MOD) + (size_t)l * NSEQ * (6 * DM);
    for (int o = tid; o < NSEQ * 64; o += 512) { const int s = o >> 6, c = o & 63; float v = a.in[10][l * (6 * DM) + n0 + c];
#pragma unroll
        for (int p = 0; p < 8; ++p) v += sl[(p * NSEQ + s) * 64 + c];
        mod[(size_t)s * (6 * DM) + n0 + c] = v; }
    __syncthreads();
}

__device__ __forceinline__ void norm_mod_rows(const float* __restrict__ xp, const float* __restrict__ xs, const float* __restrict__ gvec, const float* __restrict__ mod, int ch_shift, int ch_scale,
                                              bf16_t* __restrict__ H, int row_base, int nrows, int gw, int NGW, int lane) {
    for (int r0 = gw; r0 < nrows; r0 += 2 * NGW) {
        const int r1 = r0 + NGW; const bool two = r1 < nrows;
        const int gr0 = row_base + r0, gr1 = row_base + (two ? r1 : r0);
        const float* xrow0 = gr0 < MP ? xp + (size_t)gr0 * DM : xs + (size_t)(gr0 - MP) * DM;
        const float* xrow1 = gr1 < MP ? xp + (size_t)gr1 * DM : xs + (size_t)(gr1 - MP) * DM;
        f32x4 v0[4], v1[4]; float s0 = 0.f, s1 = 0.f;
#pragma unroll
        for (int j = 0; j < 4; ++j) { v0[j] = ((const f32x4*)xrow0)[lane + 64 * j]; v1[j] = ((const f32x4*)xrow1)[lane + 64 * j]; }
#pragma unroll
        for (int j = 0; j < 4; ++j) { s0 += (v0[j][0] * v0[j][0] + v0[j][1] * v0[j][1]) + (v0[j][2] * v0[j][2] + v0[j][3] * v0[j][3]);
                                      s1 += (v1[j][0] * v1[j][0] + v1[j][1] * v1[j][1]) + (v1[j][2] * v1[j][2] + v1[j][3] * v1[j][3]); }
        const float rstd0 = rsqrtf(wave_sum(s0) * (1.f / DM) + EPS), rstd1 = rsqrtf(wave_sum(s1) * (1.f / DM) + EPS);
#pragma unroll
        for (int q = 0; q < 2; ++q) {
            if (q == 1 && !two) break;
            const int gr = q ? gr1 : gr0, r = q ? r1 : r0; const float rstd = q ? rstd1 : rstd0;
            const int seq = gr < MP ? (gr >> 11) : NPB + ((gr - MP) >> 6);
            const float* mrow = mod + (size_t)seq * (6 * DM);
            u32x2* o8 = (u32x2*)(H + (size_t)r * DM);
            f32x4 gq[4], scq[4], shq[4];
#pragma unroll
            for (int j = 0; j < 4; ++j) { const int ci = lane + 64 * j;
                gq[j] = ((const f32x4*)gvec)[ci]; scq[j] = ((const f32x4*)(mrow + ch_scale * DM))[ci]; shq[j] = ((const f32x4*)(mrow + ch_shift * DM))[ci]; }
#pragma unroll
            for (int j = 0; j < 4; ++j) { const int ci = lane + 64 * j;
                const f32x4 y = ((q ? v1[j] : v0[j]) * rstd) * gq[j] * (scq[j] + 1.f) + shq[j];
                u32x2 w; w.x = pk2(y[0], y[1]); w.y = pk2(y[2], y[3]); o8[ci] = w; }
        }
    }
}

__device__ __forceinline__ void ynorm_rows(bf16_t* proj, const float* ssq, const float* gvec, int nrows, int gw, int NGW, int lane) {
    for (int r0 = gw; r0 < nrows; r0 += 2 * NGW) {
        const int r1 = (r0 + NGW < nrows) ? r0 + NGW : r0; const bool two = r1 != r0;
        float q0 = lane < 32 ? ssq[(size_t)r0 * NH + lane] : 0.f, q1 = lane < 32 ? ssq[(size_t)r1 * NH + lane] : 0.f;
        u32x4* row0 = (u32x4*)(proj + (size_t)r0 * PN); u32x4* row1 = (u32x4*)(proj + (size_t)r1 * PN);
        u32x4 w0[4], w1[4];
#pragma unroll
        for (int j = 0; j < 4; ++j) { w0[j] = row0[j * 64 + lane]; w1[j] = row1[j * 64 + lane]; }
        q0 += __shfl_xor(q0, 1); q0 += __shfl_xor(q0, 2); q0 += __shfl_xor(q0, 4);
        q1 += __shfl_xor(q1, 1); q1 += __shfl_xor(q1, 2); q1 += __shfl_xor(q1, 4);
        const float rs0 = rsqrtf(q0 * (1.f / 512.f) + EPS), rs1 = rsqrtf(q1 * (1.f / 512.f) + EPS);
#pragma unroll
        for (int j = 0; j < 4; ++j) { const int ci = j * 64 + lane;
            const f32x4 g0 = ((const f32x4*)gvec)[2 * ci], g1 = ((const f32x4*)gvec)[2 * ci + 1];
            { const float rj = __shfl(rs0, j * 8); const u32x4 w = w0[j];
              u32x4 o; o.x = pk2(bflo(w.x) * rj * g0[0], bfhi(w.x) * rj * g0[1]); o.y = pk2(bflo(w.y) * rj * g0[2], bfhi(w.y) * rj * g0[3]);
              o.z = pk2(bflo(w.z) * rj * g1[0], bfhi(w.z) * rj * g1[1]); o.w = pk2(bflo(w.w) * rj * g1[2], bfhi(w.w) * rj * g1[3]); row0[ci] = o; }
            { const float rj = __shfl(rs1, j * 8); const u32x4 w = w1[j];
              u32x4 o; o.x = pk2(bflo(w.x) * rj * g0[0], bfhi(w.x) * rj * g0[1]); o.y = pk2(bflo(w.y) * rj * g0[2], bfhi(w.y) * rj * g0[3]);
              o.z = pk2(bflo(w.z) * rj * g1[0], bfhi(w.z) * rj * g1[1]); o.w = pk2(bflo(w.w) * rj * g1[2], bfhi(w.w) * rj * g1[3]); if (two) row1[ci] = o; }
        }
    }
}

__device__ __forceinline__ void convbc_item(const Args& a, int layer, bool is_sample, int b, int cg32, int seq_row0, bf16_t* proj, const int tid) {
    const int oc = is_sample ? (tid & 15) : (tid & 3), ts = is_sample ? (tid >> 4) : (tid >> 2);
    const int L = is_sample ? DSEQ : SEQ, seglen = is_sample ? 2 : 16;
    const bool act = true;
    const int ch = DIN + (is_sample ? cg32 * 128 : cg32 * 32) + oc * 8;
    const int t0 = ts * seglen;
    u32x4 rw[19];
    float cw[4][8], cb[8];
    if (act) {
        const float* wp = a.in[14] + (size_t)layer * 4 * CONVC + ch; const float* bp = a.in[15] + (size_t)layer * CONVC + ch;
#pragma unroll
        for (int k = 0; k < 4; ++k) { const f32x4 w0 = *(const f32x4*)(wp + k * CONVC), w1 = *(const f32x4*)(wp + k * CONVC + 4);
            cw[k][0] = w0[0]; cw[k][1] = w0[1]; cw[k][2] = w0[2]; cw[k][3] = w0[3]; cw[k][4] = w1[0]; cw[k][5] = w1[1]; cw[k][6] = w1[2]; cw[k][7] = w1[3]; }
        const f32x4 b0 = *(const f32x4*)bp, b1 = *(const f32x4*)(bp + 4);
        cb[0] = b0[0]; cb[1] = b0[1]; cb[2] = b0[2]; cb[3] = b0[3]; cb[4] = b1[0]; cb[5] = b1[1]; cb[6] = b1[2]; cb[7] = b1[3];
#pragma unroll
        for (int r = 0; r < 19; ++r) {
            const int tt = t0 - 3 + r;
            if (r < 3 + seglen) {
                if (tt >= 0) rw[r] = *(const u32x4*)(proj + (size_t)(seq_row0 + tt) * PN + C_XBC + ch);
                else if (is_sample) { const float* pp = a.in[4] + ((size_t)(layer * NSB + b) * 3 + (3 + tt)) * CONVC + ch;
                    const f32x4 p0 = *(const f32x4*)pp, p1 = *(const f32x4*)(pp + 4);
                    rw[r].x = pk2(p0[0], p0[1]); rw[r].y = pk2(p0[2], p0[3]); rw[r].z = pk2(p1[0], p1[1]); rw[r].w = pk2(p1[2], p1[3]); }
                else rw[r] = (u32x4){0u, 0u, 0u, 0u};
            }
        }
    }
    __syncthreads();
    if (act) {
        float* nc = a.out + (is_sample ? O_CONVS + (size_t)(layer * NSB + b) * 3 * CONVC : O_CONVP + (size_t)(layer * NPB + b) * 3 * CONVC) + ch;
#pragma unroll
        for (int t = 0; t < 16; ++t) {
            if (t < seglen) {
                float o[8];
#pragma unroll
                for (int i = 0; i < 8; ++i) o[i] = cb[i];
#pragma unroll
                for (int k = 0; k < 4; ++k) { const u32x4 w = rw[t + k];
                    o[0] += cw[k][0] * bflo(w.x); o[1] += cw[k][1] * bfhi(w.x); o[2] += cw[k][2] * bflo(w.y); o[3] += cw[k][3] * bfhi(w.y);
                    o[4] += cw[k][4] * bflo(w.z); o[5] += cw[k][5] * bfhi(w.z); o[6] += cw[k][6] * bflo(w.w); o[7] += cw[k][7] * bfhi(w.w); }
                u32x4 w; w.x = pk2(siluf_(o[0]), siluf_(o[1])); w.y = pk2(siluf_(o[2]), siluf_(o[3])); w.z = pk2(siluf_(o[4]), siluf_(o[5])); w.w = pk2(siluf_(o[6]), siluf_(o[7]));
                *(u32x4*)(proj + (size_t)(seq_row0 + t0 + t) * PN + C_XBC + ch) = w;
                const int tl = t0 + t - (L - 3);
                if (tl >= 0) { const u32x4 rr = rw[t + 3]; float* q = nc + (size_t)tl * CONVC;
                    *(f32x4*)q = (f32x4){bflo(rr.x), bfhi(rr.x), bflo(rr.y), bfhi(rr.y)}; *(f32x4*)(q + 4) = (f32x4){bflo(rr.z), bfhi(rr.z), bflo(rr.w), bfhi(rr.w)}; }
            }
        }
    }
}

constexpr int P64 = 144, P128 = 272;
constexpr int L_XST = 0, L_G = L_XST + 64 * P64, L_CM = L_G + 64 * P64, L_BM = L_CM + 64 * P128, L_BWT = L_BM + 64 * P128,
              L_ST = L_BWT + 128 * P64, L_ZT = L_ST + 64 * P128, L_XRAW = L_ZT + 64 * P64, L_DT = L_XRAW + 68 * P64, L_AC = L_DT + 8192,
              L_SSQ = L_AC + 8192, L_SSQA = L_SSQ + 512, L_SSD_END = L_SSQA + 8192;
static_assert(L_SSD_END <= LDS_BYTES - 256, "ssd lds");
constexpr unsigned SSD_STEP = 64u * PN * 2u;

__device__ __forceinline__ void ssd_item(const Args& a, LAS unsigned char* lds, int layer, bool is_sample, int b, int h, int seq_row0, int nchunks,
                                         bf16_t* proj, float* ssq, const int tid) {
    const int wave = __builtin_amdgcn_readfirstlane(tid >> 6), lane = tid & 63, fr = lane & 15, fq = lane >> 4;
    const int grp = h >> 3, tok = tid >> 3, oct = tid & 7;
    float cw[4][8], cb[8];
    {
        const int chx = h * 64 + wave * 8;
        const float* wp = a.in[14] + (size_t)layer * 4 * CONVC + chx; const float* bp = a.in[15] + (size_t)layer * CONVC + chx;
#pragma unroll
        for (int k = 0; k < 4; ++k) { const f32x4 w0 = *(const f32x4*)(wp + k * CONVC), w1 = *(const f32x4*)(wp + k * CONVC + 4);
            cw[k][0] = w0[0]; cw[k][1] = w0[1]; cw[k][2] = w0[2]; cw[k][3] = w0[3]; cw[k][4] = w1[0]; cw[k][5] = w1[1]; cw[k][6] = w1[2]; cw[k][7] = w1[3]; }
        const f32x4 b0 = *(const f32x4*)bp, b1 = *(const f32x4*)(bp + 4);
        cb[0] = b0[0]; cb[1] = b0[1]; cb[2] = b0[2]; cb[3] = b0[3]; cb[4] = b1[0]; cb[5] = b1[1]; cb[6] = b1[2]; cb[7] = b1[3];
    }
    const float dtb = a.in[16][layer * NH + h], Aneg = -__expf(a.in[17][layer * NH + h]), dsk = a.in[18][layer * NH + h];
    const int pb = wave >> 1, nb0 = (wave & 1) * 4, rb = wave >> 1;
    f32x4 st[4];
    float* ssm_out = a.out + (is_sample ? O_SSMS + ((size_t)(layer * NSB + b) * NH + h) * 8192 : O_SSMP + ((size_t)(layer * NPB + b) * NH + h) * 8192);
    if (is_sample) {
        const float* sp = a.in[5] + ((size_t)(layer * NSB + b) * NH + h) * 8192;
#pragma unroll
        for (int i = 0; i < 4; ++i)
            st[i] = __builtin_nontemporal_load((const f32x4*)(sp + (16 * pb + fr) * DSTATE + 16 * (nb0 + i) + 4 * fq));
    } else {
#pragma unroll
        for (int i = 0; i < 4; ++i) st[i] = (f32x4){0.f, 0.f, 0.f, 0.f};
    }
    LAS float* dt_all = (LAS float*)(lds + L_DT); LAS float* ac_all = (LAS float*)(lds + L_AC);
    LAS float* ssqp = (LAS float*)(lds + L_SSQ);
    const char* pbase = (const char*)proj;
    const unsigned off_x = (unsigned)((seq_row0 + tok) * PN + C_XBC + h * 64 + oct * 8) * 2u;
    const unsigned off_b = (unsigned)((seq_row0 + (tid >> 4) * 2) * PN + C_XBC + DIN + grp * DSTATE + (tid & 15) * 8) * 2u;
    const unsigned off_z = (unsigned)((seq_row0 + tok) * PN + C_Z + h * 64 + oct * 8) * 2u;
    u32x4 xv, xh = (u32x4){0u, 0u, 0u, 0u}, bv0, bv1, cv0, cv1, zv;
    xv = *(const u32x4*)(pbase + off_x); bv0 = *(const u32x4*)(pbase + off_b); bv1 = *(const u32x4*)(pbase + off_b + PN * 2); cv0 = *(const u32x4*)(pbase + off_b + 1024); cv1 = *(const u32x4*)(pbase + off_b + PN * 2 + 1024);
    zv = *(const u32x4*)(pbase + off_z);
    {
        bf16_t dr[4];
#pragma unroll
        for (int q = 0; q < 4; ++q) { const int cc = wave + 8 * q; dr[q] = cc < nchunks ? proj[(size_t)(seq_row0 + cc * 64 + lane) * PN + C_DT + h] : (bf16_t)0; }
#pragma unroll
        for (int q = 0; q < 4; ++q) { const int cc = wave + 8 * q;
            if (cc < nchunks) {
                const float x = bf2f(dr[q]) + dtb;
                const float dt = x > 20.f ? x : log1pf(__expf(x));
                float sc = dt * Aneg;
#pragma unroll
                for (int off = 1; off < 64; off <<= 1) { const float v = __shfl_up(sc, off); if (lane >= off) sc += v; }
                dt_all[cc * 64 + lane] = dt; ac_all[cc * 64 + lane] = sc * 1.4426950408889634f; } }
    }
    if (is_sample && tid < 24) { const float* pp = a.in[4] + ((size_t)(layer * NSB + b) * 3 + tok) * CONVC + h * 64 + oct * 8;
        const f32x4 p0 = *(const f32x4*)pp, p1 = *(const f32x4*)(pp + 4);
        xh.x = pk2(p0[0], p0[1]); xh.y = pk2(p0[2], p0[3]); xh.z = pk2(p1[0], p1[1]); xh.w = pk2(p1[2], p1[3]); }
#pragma unroll 1
    for (int c = 0; c < nchunks; ++c) {
        const unsigned cs = (unsigned)c * SSD_STEP;
        const LAS float* dtv = dt_all + c * 64; const LAS float* acv = ac_all + c * 64;
        *(LAS u32x4*)(lds + L_XRAW + (3 + tok) * P64 + oct * 16) = xv;
        if (tid < 24) *(LAS u32x4*)(lds + L_XRAW + tok * P64 + oct * 16) = xh;
        { const int oc = tid & 15, tk = (tid >> 4) * 2;
          *(LAS u32x4*)(lds + L_BM + tk * P128 + oc * 16) = bv0; *(LAS u32x4*)(lds + L_BM + (tk + 1) * P128 + oc * 16) = bv1;
          *(LAS u32x4*)(lds + L_CM + tk * P128 + oc * 16) = cv0; *(LAS u32x4*)(lds + L_CM + (tk + 1) * P128 + oc * 16) = cv1; }
        {
            const u32x4 yv = *(const LAS u32x4*)(lds + L_ZT + tok * P64 + oct * 16);
            *(LAS u32x4*)(lds + L_ZT + tok * P64 + oct * 16) = zv;
            if (c > 0) *(u32x4*)(const_cast<char*>(pbase) + off_z + cs - SSD_STEP) = yv; }
#pragma unroll
        for (int i = 0; i < 4; ++i) { u32x2 w; w.x = pk2(st[i][0], st[i][1]); w.y = pk2(st[i][2], st[i][3]);
            *(LAS u32x2*)(lds + L_ST + (16 * pb + fr) * P128 + (16 * (nb0 + i) + 4 * fq) * 2) = w; }
        LBAR();
        const u32x4 bo0 = bv0, bo1 = bv1;
        if (c + 1 < nchunks) {
            const unsigned cn = cs + SSD_STEP;
            xv = *(const u32x4*)(pbase + off_x + cn); if (tid < 24) xh = *(const u32x4*)(pbase + off_x + cn - 3u * PN * 2u);
            bv0 = *(const u32x4*)(pbase + off_b + cn); bv1 = *(const u32x4*)(pbase + off_b + cn + PN * 2); cv0 = *(const u32x4*)(pbase + off_b + cn + 1024); cv1 = *(const u32x4*)(pbase + off_b + cn + PN * 2 + 1024);
            zv = *(const u32x4*)(pbase + off_z + cn);
        }
        {
            float o[8];
#pragma unroll
            for (int i = 0; i < 8; ++i) o[i] = cb[i];
#pragma unroll
            for (int k = 0; k < 4; ++k) { const u32x4 w = *(const LAS u32x4*)(lds + L_XRAW + (lane + k) * P64 + wave * 16);
                o[0] += cw[k][0] * bflo(w.x); o[1] += cw[k][1] * bfhi(w.x); o[2] += cw[k][2] * bflo(w.y); o[3] += cw[k][3] * bfhi(w.y);
                o[4] += cw[k][4] * bflo(w.z); o[5] += cw[k][5] * bfhi(w.z); o[6] += cw[k][6] * bflo(w.w); o[7] += cw[k][7] * bfhi(w.w); }
#pragma unroll
            for (int i = 0; i < 8; ++i) *(LAS bf16_t*)(lds + L_XST + (wave * 8 + i) * P64 + lane * 2) = f2bf(siluf_(o[i]));
        }
        {
            const int oc = tid & 15, tk = (tid >> 4) * 2;
            const float a63s = acv[63]; const float wa = dtv[tk] * __builtin_amdgcn_exp2f(a63s - acv[tk]), wb = dtv[tk + 1] * __builtin_amdgcn_exp2f(a63s - acv[tk + 1]);
            LAS unsigned char* d = lds + L_BWT + (oc * 8) * P64 + ((((tk >> 3) ^ ((oc >> 1) & 7)) << 4) | ((tk * 2) & 15));
            *(LAS unsigned*)(d + 0 * P64) = pk2(bflo(bo0.x) * wa, bflo(bo1.x) * wb); *(LAS unsigned*)(d + 1 * P64) = pk2(bfhi(bo0.x) * wa, bfhi(bo1.x) * wb);
            *(LAS unsigned*)(d + 2 * P64) = pk2(bflo(bo0.y) * wa, bflo(bo1.y) * wb); *(LAS unsigned*)(d + 3 * P64) = pk2(bfhi(bo0.y) * wa, bfhi(bo1.y) * wb);
            *(LAS unsigned*)(d + 4 * P64) = pk2(bflo(bo0.z) * wa, bflo(bo1.z) * wb); *(LAS unsigned*)(d + 5 * P64) = pk2(bfhi(bo0.z) * wa, bfhi(bo1.z) * wb);
            *(LAS unsigned*)(d + 6 * P64) = pk2(bflo(bo0.w) * wa, bflo(bo1.w) * wb); *(LAS unsigned*)(d + 7 * P64) = pk2(bfhi(bo0.w) * wa, bfhi(bo1.w) * wb);
        }
        {
            float al[4];
#pragma unroll
            for (int j = 0; j < 4; ++j) al[j] = acv[16 * rb + 4 * fq + j];
#pragma unroll
            for (int ci = 0; ci < 2; ++ci) { const int cbk = (wave & 1) * 2 + ci; f32x4 acc = (f32x4){0.f, 0.f, 0.f, 0.f};
#pragma unroll
                for (int ks = 0; ks < 4; ++ks) { const bf16x8 av = *(const LAS bf16x8*)(lds + L_CM + (16 * rb + fr) * P128 + (32 * ks + 8 * fq) * 2);
                    const bf16x8 bv = *(const LAS bf16x8*)(lds + L_BM + (16 * cbk + fr) * P128 + (32 * ks + 8 * fq) * 2); acc = mfma16(av, bv, acc); }
                const int s = 16 * cbk + fr; const float as = acv[s], ds = dtv[s];
#pragma unroll
                for (int j = 0; j < 4; ++j) { const int l = 16 * rb + 4 * fq + j;
                    const float gv = (s <= l) ? acc[j] * __builtin_amdgcn_exp2f(al[j] - as) * ds : 0.f;
                    *(LAS bf16_t*)(lds + L_G + l * P64 + s * 2) = f2bf(gv); } }
        }
        LBAR();
        {
            float sq[4] = {0.f, 0.f, 0.f, 0.f}, el[4];
#pragma unroll
            for (int j = 0; j < 4; ++j) el[j] = __builtin_amdgcn_exp2f(acv[16 * rb + 4 * fq + j]);
#pragma unroll
            for (int ci = 0; ci < 2; ++ci) { const int cbk = (wave & 1) * 2 + ci; f32x4 acc = (f32x4){0.f, 0.f, 0.f, 0.f}, acp = (f32x4){0.f, 0.f, 0.f, 0.f};
#pragma unroll
                for (int ks = 0; ks < 2; ++ks) { const bf16x8 av = *(const LAS bf16x8*)(lds + L_G + (16 * rb + fr) * P64 + (32 * ks + 8 * fq) * 2);
                    const bf16x8 bv = *(const LAS bf16x8*)(lds + L_XST + (16 * cbk + fr) * P64 + (32 * ks + 8 * fq) * 2); acc = mfma16(av, bv, acc); }
#pragma unroll
                for (int ks = 0; ks < 4; ++ks) { const bf16x8 av = *(const LAS bf16x8*)(lds + L_CM + (16 * rb + fr) * P128 + (32 * ks + 8 * fq) * 2);
                    const bf16x8 bv = *(const LAS bf16x8*)(lds + L_ST + (16 * cbk + fr) * P128 + (32 * ks + 8 * fq) * 2); acp = mfma16(av, bv, acp); }
                const int p = 16 * cbk + fr;
                const u32x2 xs4 = *(const LAS u32x2*)(lds + L_XST + p * P64 + (16 * rb + 4 * fq) * 2);
                const float xsv[4] = {bflo(xs4.x), bfhi(xs4.x), bflo(xs4.y), bfhi(xs4.y)};
#pragma unroll
                for (int j = 0; j < 4; ++j) { const int l = 16 * rb + 4 * fq + j;
                    LAS bf16_t* zp = (LAS bf16_t*)(lds + L_ZT + l * P64 + p * 2);
                    const float z = bf2f(*zp);
                    const float yg = (acc[j] + el[j] * acp[j] + xsv[j] * dsk) * siluf_(z);
                    *zp = f2bf(yg); sq[j] += yg * yg; } }
#pragma unroll
            for (int j = 0; j < 4; ++j) { const float v = row16_sum(sq[j]);
                if (fr == 0) ssqp[(16 * rb + 4 * fq + j) * 2 + (wave & 1)] = v; }
            const float dec = __builtin_amdgcn_exp2f(acv[63]);
#pragma unroll
            for (int i = 0; i < 4; ++i) { st[i] = st[i] * dec;
#pragma unroll
                for (int ks = 0; ks < 2; ++ks) { const bf16x8 av = *(const LAS bf16x8*)(lds + L_XST + (16 * pb + fr) * P64 + (32 * ks + 8 * fq) * 2);
                    const bf16x8 bv = *(const LAS bf16x8*)(lds + L_BWT + (16 * (nb0 + i) + fr) * P64 + (((4 * ks + fq) ^ ((nb0 + i) & 7)) << 4)); st[i] = mfma16(bv, av, st[i]); } }
        }
        LBAR();
        if (tid < 64) ((LAS float*)(lds + L_SSQA))[c * 64 + tid] = ssqp[tid * 2] + ssqp[tid * 2 + 1];
    }
    LBAR();
    for (int t = tid; t < nchunks * 64; t += 512) ssq[(size_t)(seq_row0 + t) * NH + h] = ((const LAS float*)(lds + L_SSQA))[t];
    { const u32x4 yv = *(const LAS u32x4*)(lds + L_ZT + tok * P64 + oct * 16); *(u32x4*)(const_cast<char*>(pbase) + off_z + (unsigned)(nchunks - 1) * SSD_STEP) = yv; }
#pragma unroll
    for (int i = 0; i < 4; ++i) __builtin_nontemporal_store(st[i], (f32x4*)(ssm_out + (16 * pb + fr) * DSTATE + 16 * (nb0 + i) + 4 * fq));
    LBAR();
}

constexpr int PK = 144, PV = 400;
constexpr int L_KS = 0, L_VT = L_KS + 192 * PK, L_BT = L_VT + 64 * PV, L_ATT_END = L_BT + 4 * 256 * 4;
static_assert(L_ATT_END <= 131072, "attn lds");

__device__ __forceinline__ void attn_item(const Args& a, LAS unsigned char* lds, int layer, bool is_sample, int b, int c, int kvh, int seq_row0, int nchunks, bf16_t* proj, const int tid) {
    const int wave = __builtin_amdgcn_readfirstlane(tid >> 6), lane = tid & 63, fr = lane & 15, fq = lane >> 4;
    const int row0 = seq_row0 + c * 64;
    const float* kng = a.in[21] + layer * 64;
    u32x4 qraw[2][2];
    {
        const int hq_ = kvh * 4 + (wave >> 1);
#pragma unroll
        for (int sub = 0; sub < 2; ++sub) { const bf16_t* qp_ = proj + (size_t)(row0 + (wave & 1) * 32 + sub * 16 + fr) * PN + C_Q + hq_ * 64;
#pragma unroll
            for (int ks = 0; ks < 2; ++ks) qraw[sub][ks] = *(const u32x4*)(qp_ + 32 * ks + 8 * fq); }
    }
#pragma unroll
    for (int i = 0; i < 3; ++i) {
        const int slot = tid + 512 * i, kl = slot >> 3, oc = slot & 7;
        const int pos = c * 64 - 128 + kl;
        float kf[8], vf[8];
        if (is_sample && kl < 128) {
            const size_t off = (((size_t)(layer * NSB + b) * 128 + kl) * NKVH + kvh) * 64 + oc * 8;
            const f32x4 k0 = *(const f32x4*)(a.in[2] + off), k1 = *(const f32x4*)(a.in[2] + off + 4), v0 = *(const f32x4*)(a.in[3] + off), v1 = *(const f32x4*)(a.in[3] + off + 4);
#pragma unroll
            for (int e = 0; e < 4; ++e) { kf[e] = k0[e]; kf[4 + e] = k1[e]; vf[e] = v0[e]; vf[4 + e] = v1[e]; }
        } else if (pos >= 0) {
            const bf16_t* rp = proj + (size_t)(seq_row0 + pos) * PN;
            const u32x4 kw = *(const u32x4*)(rp + C_K + kvh * 64 + oc * 8), vw = *(const u32x4*)(rp + C_V + kvh * 64 + oc * 8);
            kf[0] = bflo(kw.x); kf[1] = bfhi(kw.x); kf[2] = bflo(kw.y); kf[3] = bfhi(kw.y); kf[4] = bflo(kw.z); kf[5] = bfhi(kw.z); kf[6] = bflo(kw.w); kf[7] = bfhi(kw.w);
            vf[0] = bflo(vw.x); vf[1] = bfhi(vw.x); vf[2] = bflo(vw.y); vf[3] = bfhi(vw.y); vf[4] = bflo(vw.z); vf[5] = bfhi(vw.z); vf[6] = bflo(vw.w); vf[7] = bfhi(vw.w);
            float ss = 0.f;
#pragma unroll
            for (int e = 0; e < 8; ++e) ss += kf[e] * kf[e];
            ss += __shfl_xor(ss, 1); ss += __shfl_xor(ss, 2); ss += __shfl_xor(ss, 4);
            const float rs = rsqrtf(ss * (1.f / 64.f) + EPS);
            const f32x4 g0 = *(const f32x4*)(kng + oc * 8), g1 = *(const f32x4*)(kng + oc * 8 + 4);
#pragma unroll
            for (int e = 0; e < 4; ++e) { kf[e] = kf[e] * rs * g0[e]; kf[4 + e] = kf[4 + e] * rs * g1[e]; }
            if (kl >= 128 && (is_sample || c >= nchunks - 2)) {
                const int orow = is_sample ? (kl - 128) : (c - (nchunks - 2)) * 64 + (kl - 128);
                const size_t nb_ = is_sample ? NSB : NPB; const int lr = is_sample ? DSEQ : 128;
                const size_t off = (((size_t)(layer * nb_ + b) * lr + orow) * NKVH + kvh) * 64 + oc * 8;
                float* ko = a.out + (is_sample ? O_KS : O_KP) + off; float* vo = a.out + (is_sample ? O_VS : O_VP) + off;
                *(f32x4*)ko = (f32x4){kf[0], kf[1], kf[2], kf[3]}; *(f32x4*)(ko + 4) = (f32x4){kf[4], kf[5], kf[6], kf[7]};
                *(f32x4*)vo = (f32x4){vf[0], vf[1], vf[2], vf[3]}; *(f32x4*)(vo + 4) = (f32x4){vf[4], vf[5], vf[6], vf[7]};
            }
        } else {
#pragma unroll
            for (int e = 0; e < 8; ++e) { kf[e] = 0.f; vf[e] = 0.f; }
        }
        u32x4 w; w.x = pk2(kf[0], kf[1]); w.y = pk2(kf[2], kf[3]); w.z = pk2(kf[4], kf[5]); w.w = pk2(kf[6], kf[7]);
        *(LAS u32x4*)(lds + L_KS + kl * PK + oc * 16) = w;
#pragma unroll
        for (int e = 0; e < 8; ++e) *(LAS bf16_t*)(lds + L_VT + (oc * 8 + e) * PV + (kl ^ (oc << 2)) * 2) = f2bf(vf[e]);
    }
    LAS float* bt = (LAS float*)(lds + L_BT);
    for (int idx = tid; idx < 1024; idx += 512) { const int g = idx >> 8, ri = idx & 255; const int rel = ri - 191;
        int n = -rel; int ret = n < 0 ? 16 : 0; n = n < 0 ? -n : n;
        int bk;
        if (n < 8) bk = n; else if (n < 12) bk = 8; else if (n < 16) bk = 9; else if (n < 23) bk = 10; else if (n < 32) bk = 11; else if (n < 46) bk = 12; else if (n < 64) bk = 13; else if (n < 91) bk = 14; else bk = 15;
        bt[idx] = a.in[8][(ret + bk) * NQH + kvh * 4 + g] * 1.4426950408889634f; }
    __syncthreads();
    const int g = wave >> 1, hq = kvh * 4 + g;
    const float sink = a.in[22][layer * NQH + hq] * 1.4426950408889634f;
    const float* qng = a.in[20] + layer * 64;
    const int kmin = is_sample ? 0 : (2 - c) * 64;
#pragma unroll 1
    for (int sub = 0; sub < 2; ++sub) {
        const int ql = (wave & 1) * 32 + sub * 16 + fr;
        bf16_t* qp = proj + (size_t)(row0 + ql) * PN + C_Q + hq * 64;
        bf16x8 qf[2];
        {
            float qv[2][8]; float ss = 0.f;
#pragma unroll
            for (int ks = 0; ks < 2; ++ks) { const u32x4 w = sub ? qraw[1][ks] : qraw[0][ks];
                qv[ks][0] = bflo(w.x); qv[ks][1] = bfhi(w.x); qv[ks][2] = bflo(w.y); qv[ks][3] = bfhi(w.y); qv[ks][4] = bflo(w.z); qv[ks][5] = bfhi(w.z); qv[ks][6] = bflo(w.w); qv[ks][7] = bfhi(w.w);
#pragma unroll
                for (int e = 0; e < 8; ++e) ss += qv[ks][e] * qv[ks][e]; }
            ss += __shfl_xor(ss, 16); ss += __shfl_xor(ss, 32);
            const float rs = rsqrtf(ss * (1.f / 64.f) + EPS) * (0.125f * 1.4426950408889634f);
#pragma unroll
            for (int ks = 0; ks < 2; ++ks) { const f32x4 g0 = *(const f32x4*)(qng + 32 * ks + 8 * fq), g1 = *(const f32x4*)(qng + 32 * ks + 8 * fq + 4);
                u32x4 w; w.x = pk2(qv[ks][0] * rs * g0[0], qv[ks][1] * rs * g0[1]); w.y = pk2(qv[ks][2] * rs * g0[2], qv[ks][3] * rs * g0[3]);
                w.z = pk2(qv[ks][4] * rs * g1[0], qv[ks][5] * rs * g1[1]); w.w = pk2(qv[ks][6] * rs * g1[2], qv[ks][7] * rs * g1[3]);
                qf[ks] = __builtin_bit_cast(bf16x8, w); }
        }
        f32x4 sacc[12];
#pragma unroll
        for (int kb = 0; kb < 12; ++kb) { sacc[kb] = (f32x4){0.f, 0.f, 0.f, 0.f};
#pragma unroll
            for (int ks = 0; ks < 2; ++ks) { const bf16x8 av = *(const LAS bf16x8*)(lds + L_KS + (16 * kb + fr) * PK + (32 * ks + 8 * fq) * 2); sacc[kb] = mfma16(av, qf[ks], sacc[kb]); } }
        float mx = sink;
#pragma unroll
        for (int kb = 0; kb < 12; ++kb)
#pragma unroll
            for (int j = 0; j < 4; ++j) { const int kl = 16 * kb + 4 * fq + j;
                const float s = sacc[kb][j] + bt[g * 256 + kl - 128 - ql + 191];
                sacc[kb][j] = s; mx = fmaxf(mx, s); }
        if (kmin > 0) {
            mx = sink;
#pragma unroll
            for (int kb = 0; kb < 12; ++kb)
#pragma unroll
                for (int j = 0; j < 4; ++j) { const int kl = 16 * kb + 4 * fq + j; if (kl < kmin) sacc[kb][j] = -INFINITY; mx = fmaxf(mx, sacc[kb][j]); }
        }
        mx = fmaxf(mx, __shfl_xor(mx, 16)); mx = fmaxf(mx, __shfl_xor(mx, 32));
        float sum = 0.f;
#pragma unroll
        for (int kb = 0; kb < 12; ++kb)
#pragma unroll
            for (int j = 0; j < 4; ++j) { const float p = __builtin_amdgcn_exp2f(sacc[kb][j] - mx); sacc[kb][j] = p; sum += p; }
        sum += __shfl_xor(sum, 16); sum += __shfl_xor(sum, 32);
        const float inv = __builtin_amdgcn_rcpf(sum + __builtin_amdgcn_exp2f(sink - mx));
        f32x4 oacc[4];
#pragma unroll
        for (int db = 0; db < 4; ++db) oacc[db] = (f32x4){0.f, 0.f, 0.f, 0.f};
#pragma unroll
        for (int ks = 0; ks < 6; ++ks) {
            u32x4 pw; pw.x = pk2(sacc[2 * ks][0], sacc[2 * ks][1]); pw.y = pk2(sacc[2 * ks][2], sacc[2 * ks][3]); pw.z = pk2(sacc[2 * ks + 1][0], sacc[2 * ks + 1][1]); pw.w = pk2(sacc[2 * ks + 1][2], sacc[2 * ks + 1][3]);
            const bf16x8 pbv = __builtin_bit_cast(bf16x8, pw);
#pragma unroll
            for (int db = 0; db < 4; ++db) { const LAS unsigned char* vr = lds + L_VT + (16 * db + fr) * PV; const int vkey = ((2 * db + (fr >> 3)) & 7) << 2;
                const u32x2 lo = *(const LAS u32x2*)(vr + ((32 * ks + 4 * fq) ^ vkey) * 2), hi = *(const LAS u32x2*)(vr + ((32 * ks + 16 + 4 * fq) ^ vkey) * 2);
                u32x4 vw; vw.x = lo.x; vw.y = lo.y; vw.z = hi.x; vw.w = hi.y;
                oacc[db] = mfma16(__builtin_bit_cast(bf16x8, vw), pbv, oacc[db]); }
        }
#pragma unroll
        for (int db = 0; db < 4; ++db) { u32x2 w; w.x = pk2(oacc[db][0] * inv, oacc[db][1] * inv); w.y = pk2(oacc[db][2] * inv, oacc[db][3] * inv);
            *(u32x2*)(qp + 16 * db + 4 * fq) = w; }
    }
    __syncthreads();
}

#define XB_TMO      128
#define XB_XCNT(j)  (256  + 64 * (j))
#define XB_XSUB(j)  (1280 + 64 * (j))
#define XB_XGEN(j)  (2304 + 64 * (j))
#define XB_TOP      3328
#define XB_TOPGEN   3392
#define XCD_BAR_WORDS 3456
#define XB_SPIN_CAP (1u << 22)
__device__ __forceinline__ unsigned xb_ld(unsigned* p)              { return __hip_atomic_load(p, __ATOMIC_RELAXED, __HIP_MEMORY_SCOPE_AGENT); }
__device__ __forceinline__ unsigned xb_add(unsigned* p, unsigned v) { return __hip_atomic_fetch_add(p, v, __ATOMIC_RELAXED, __HIP_MEMORY_SCOPE_AGENT); }
__device__ __forceinline__ unsigned xb_xcc_id() { return (unsigned)__builtin_amdgcn_s_getreg((3 << 11) | 20) & 0xFu; }
#define XB_SPIN(cond, bar) do { unsigned _sp = 0; while (cond) { __builtin_amdgcn_s_sleep(1); \
    if ((++_sp & 255u) == 0u) { if (xb_ld(&(bar)[XB_TMO])) break; if (_sp > XB_SPIN_CAP) { atomicAdd(&(bar)[XB_TMO], 1u); break; } } } } while (0)
struct XcdBarrier { unsigned* bar; unsigned x; volatile LAS unsigned* st; };
__device__ __forceinline__ XcdBarrier xcd_barrier_post(unsigned* bar, volatile LAS unsigned* st) {
    XcdBarrier b; b.bar = bar; b.x = xb_xcc_id(); b.st = st;
    if (threadIdx.x == 0) (void)xb_add(&bar[XB_XCNT(b.x)], 1u);
    return b;
}
__device__ __forceinline__ void xcd_barrier_complete(unsigned* bar, unsigned x, unsigned& nloc, unsigned& nx) {
    const unsigned G = gridDim.x * gridDim.y * gridDim.z;
    unsigned sum, cnt, mine, sp = 0u;
    for (;;) {
        sum = 0u; cnt = 0u; mine = 0u;
#pragma unroll
        for (unsigned j = 0; j < 16; ++j) { const unsigned c = xb_ld(&bar[XB_XCNT(j)]); sum += c; cnt += (c > 0u) ? 1u : 0u; mine = (j == x) ? c : mine; }
        if (sum == G) break;
        __builtin_amdgcn_s_sleep(1);
        if ((++sp & 255u) == 0u) { if (xb_ld(&bar[XB_TMO])) break; if (sp > XB_SPIN_CAP) { atomicAdd(&bar[XB_TMO], 1u); break; } }
    }
    nloc = mine > 0u ? mine : 1u; nx = cnt > 0u ? cnt : 1u;
}
__device__ __forceinline__ void xcd_barrier(const XcdBarrier& b) {
    asm volatile("s_waitcnt vmcnt(0)" ::: "memory");
    __syncthreads();
    if (threadIdx.x == 0) {
        unsigned* bar = b.bar;
        __builtin_amdgcn_s_waitcnt(0);
        unsigned nloc = b.st[0], nx = b.st[1];
        if (nloc == 0u) { xcd_barrier_complete(bar, b.x, nloc, nx); b.st[0] = nloc; b.st[1] = nx; }
        const unsigned old = xb_add(&bar[XB_XSUB(b.x)], 1u);
        const unsigned gen = old / nloc;
        if (old + 1u == (gen + 1u) * nloc) {
            __builtin_amdgcn_fence(__ATOMIC_RELEASE, "agent");
            asm volatile("s_waitcnt vmcnt(0)" ::: "memory");
            const unsigned og = xb_add(&bar[XB_TOP], 1u);
            const unsigned tg = og / nx;
            if (og + 1u == (tg + 1u) * nx) xb_add(&bar[XB_TOPGEN], 1u);
            else XB_SPIN(xb_ld(&bar[XB_TOPGEN]) == tg, bar);
            __builtin_amdgcn_fence(__ATOMIC_ACQUIRE, "agent");
            xb_add(&bar[XB_XGEN(b.x)], 1u);
            asm volatile("s_waitcnt vmcnt(0)" ::: "memory");
        } else {
            XB_SPIN(xb_ld(&bar[XB_XGEN(b.x)]) == gen, bar);
            __builtin_amdgcn_fence(__ATOMIC_ACQUIRE, "agent");
            asm volatile("s_waitcnt vmcnt(0)" ::: "memory");
        }
    }
    __syncthreads();
}

#define OPAQUE_TID() int tq = threadIdx.x; asm volatile("" : "+v"(tq))
__global__ void __launch_bounds__(512, 2) mega_fwd(Args a) {
    extern __shared__ __attribute__((aligned(16))) unsigned char lds_raw[];
    LAS unsigned char* lds = (LAS unsigned char*)lds_raw;
    cg::grid_group grid = cg::this_grid();
    const int tid = threadIdx.x, lane = tid & 63, wave = __builtin_amdgcn_readfirstlane(tid >> 6);
    const int G = gridDim.x, bx = blockIdx.x, gw = bx * 8 + wave, NGW = G * 8;
    bf16_t* Hb = (bf16_t*)(a.ws + WS_H); bf16_t* proj = (bf16_t*)(a.ws + WS_PROJ); float* ssq = (float*)(a.ws + WS_SSQ);
    const float* modall = (const float*)(a.ws + WS_MOD);

    for (int w = bx * 512 + tid; w < XCD_BAR_WORDS; w += G * 512) __hip_atomic_store((unsigned*)(a.ws + WS_CTL) + w, 0u, __ATOMIC_RELAXED, __HIP_MEMORY_SCOPE_AGENT);
    prologue_weights(a, lds, gw, NGW, wave, lane);
    for (int it = bx; it < 192; it += G) prologue_mod_item(a, lds, it, tid);
    volatile LAS unsigned* bst = (volatile LAS unsigned*)(lds + LDS_BYTES - 64);
    if (tid < 2) bst[tid] = 0u;
    __syncthreads();
    grid.sync();
    XcdBarrier xbar = xcd_barrier_post((unsigned*)(a.ws + WS_CTL), bst);

#pragma unroll 1
    for (int layer = 0; layer < 2; ++layer) {
#pragma unroll 1
        for (int slab = 0; slab < 2; ++slab) {
            const int row_base = slab * SLAB0_ROWS, nrows = slab == 0 ? SLAB0_ROWS : SLAB1_ROWS, nMt = nrows / 256;
            const unsigned char* wl = a.ws + (size_t)layer * W_LAYER;
            const float* mod = modall + (size_t)layer * NSEQ * (6 * DM);
            const float* xin_p = layer == 0 ? a.in[0] : a.out + O_Y;
            const float* xin_s = layer == 0 ? a.in[1] : a.out + O_Y + (size_t)MP * DM;
            { OPAQUE_TID(); norm_mod_rows(xin_p, xin_s, a.in[11] + layer * DM, mod, 0, 1, Hb, row_base, nrows, gw, NGW, tq & 63); }
            xcd_barrier(xbar);
            { pg8::Gemm g; g.A0 = g.A1 = g.A2 = Hb; g.B0 = g.B1 = g.B2 = (const bf16_t*)(wl + W_IN); g.K0 = g.K1 = g.K2 = DM; g.lda = DM; g.ldb = DM;
              pg8::StaticOrder S; S.init(nMt, PN / 256, G, bx, 1); EpiProj E{proj, PN};
              OPAQUE_TID(); pg8::gemm_phase<EpiProj>(lds, g, S, E, tq); }
            xcd_barrier(xbar);
            {
                const int nCp = 8 * 32, nCs = slab == 0 ? 0 : NSB * 8;
                for (int L = bx; L < nCp + nCs; L += G) {
                    OPAQUE_TID();
                    if (L < nCp) { const int b = slab * 8 + (L >> 5); convbc_item(a, layer, false, b, L & 31, b * SEQ - row_base, proj, tq); }
                    else { const int r = L - nCp, b = r >> 3; convbc_item(a, layer, true, b, r & 7, MP + b * DSEQ - row_base, proj, tq); }
                    __syncthreads();
                }
            }
            xcd_barrier(xbar);
            {
                const int npseq = 8, nsseq = slab == 0 ? 0 : NSB;
                OPAQUE_TID();
                for (int idx = bx * 512 + tq; idx < (npseq + nsseq) * 3 * DIN; idx += G * 512) {
                    const int sq = idx / (3 * DIN), rem = idx - sq * (3 * DIN), r = rem / DIN, chn = rem - r * DIN;
                    if (sq < npseq) { const int b = slab * 8 + sq; const int lrow = b * SEQ - row_base + (SEQ - 3 + r);
                        a.out[O_CONVP + ((size_t)(layer * NPB + b) * 3 + r) * CONVC + chn] = bf2f(proj[(size_t)lrow * PN + C_XBC + chn]); }
                    else { const int b = sq - npseq; const int lrow = MP + b * DSEQ - row_base + (DSEQ - 3 + r);
                        a.out[O_CONVS + ((size_t)(layer * NSB + b) * 3 + r) * CONVC + chn] = bf2f(proj[(size_t)lrow * PN + C_XBC + chn]); }
                }
                const int nP = 8 * NH, nS = slab == 0 ? 0 : NSB * NH, nAp = 8 * 32 * NKVH, nAs = slab == 0 ? 0 : NSB * NKVH;
                const int total = nP + nS + nAp + nAs;
                for (int L = bx; L < total; L += G) {
                    int r = L;
                    if (r < nP) { const int b = slab * 8 + r / NH, h = r % NH; OPAQUE_TID(); ssd_item(a, lds, layer, false, b, h, b * SEQ - row_base, 32, proj, ssq, tq); continue; } r -= nP;
                    if (r < nS) { const int b = r / NH, h = r % NH; OPAQUE_TID(); ssd_item(a, lds, layer, true, b, h, MP + b * DSEQ - row_base, 1, proj, ssq, tq); continue; } r -= nS;
                    if (r < nAp) { const int kvh = r & 3, c = (r >> 2) & 31, b = slab * 8 + (r >> 7); OPAQUE_TID(); attn_item(a, lds, layer, false, b, c, kvh, b * SEQ - row_base, 32, proj, tq); continue; } r -= nAp;
                    { const int kvh = r & 3, b = r >> 2; OPAQUE_TID(); attn_item(a, lds, layer, true, b, 0, kvh, MP + b * DSEQ - row_base, 1, proj, tq); }
                }
            }
            xcd_barrier(xbar);
            { pg8::Gemm g; g.A0 = proj + C_Z; g.A1 = g.A2 = proj + C_Q; g.B0 = (const bf16_t*)(wl + W_BR); g.B1 = g.B2 = (const bf16_t*)(wl + W_BR) + 2048; g.K0 = DIN; g.K1 = g.K2 = DM; g.lda = PN; g.ldb = 3072;
              pg8::StaticOrder S; S.init(nMt, 4, G, bx, 2); EpiBr E{proj, Hb};
              OPAQUE_TID();
              {
                  Unit u; const int k = tq >> 8, row = tq & 255;
                  if (S.next(2 * k, u)) {
                      const f32x4* q = (const f32x4*)(ssq + (size_t)(u.pm * 256 + row) * NH);
                      float r[4];
#pragma unroll
                      for (int gq = 0; gq < 4; ++gq) { const f32x4 x0 = q[2 * gq], x1 = q[2 * gq + 1]; r[gq] = rsqrtf(((x0[0] + x0[1]) + (x0[2] + x0[3]) + (x1[0] + x1[1]) + (x1[2] + x1[3])) * (1.f / 512.f) + EPS); }
                      *(LAS f32x4*)(lds + pg8::STAGE_BYTES + (k * 256 + row) * 16) = (f32x4){r[0] / r[1], r[1] / r[2], r[2] / r[3], r[3]};
                  }
                  __syncthreads();
              }
              pg8::gemm_phase<EpiBr, true>(lds, g, S, E, tq); }
            xcd_barrier(xbar);
            { pg8::Gemm g; g.A0 = g.A1 = g.A2 = Hb; g.B0 = g.B1 = g.B2 = (const bf16_t*)(wl + W_O); g.K0 = g.K1 = g.K2 = DM; g.lda = DM; g.ldb = DM;
              pg8::StaticOrder S; S.init(nMt, 4, G, bx, 1); EpiRes E{xin_p, xin_s, a.out + O_Y, mod + 2 * DM, row_base};
              OPAQUE_TID(); pg8::gemm_phase<EpiRes>(lds, g, S, E, tq); }
            xcd_barrier(xbar);
        }
        {
            const unsigned char* wl = a.ws + (size_t)layer * W_LAYER;
            const float* mod = modall + (size_t)layer * NSEQ * (6 * DM);
            { OPAQUE_TID(); norm_mod_rows(a.out + O_Y, a.out + O_Y + (size_t)MP * DM, a.in[12] + layer * DM, mod, 3, 4, Hb, 0, MTOT, gw, NGW, tq & 63); }
            xcd_barrier(xbar);
            { pg8::Gemm g; g.A0 = g.A1 = g.A2 = Hb; g.B0 = g.B1 = g.B2 = (const bf16_t*)(wl + W_GU); g.K0 = g.K1 = g.K2 = DM; g.lda = DM; g.ldb = DM;
              pg8::StaticOrder S; S.init(MTOT / 256, 2 * DFF / 256, G, bx, 1); EpiSwiglu E{proj};
              OPAQUE_TID(); pg8::gemm_phase<EpiSwiglu>(lds, g, S, E, tq); }
            xcd_barrier(xbar);
            { pg8::Gemm g; g.A0 = g.A1 = proj; g.A2 = proj + DFF / 2; g.B0 = g.B1 = (const bf16_t*)(wl + W_D); g.B2 = (const bf16_t*)(wl + W_D) + DFF / 2; g.K0 = DFF; g.K1 = g.K2 = DFF / 2; g.lda = DFF; g.ldb = DFF;
              pg8::StaticOrder S; S.init(MTOT / 256, 4, G, bx, 1, false);    EpiRes E{a.out + O_Y, a.out + O_Y + (size_t)MP * DM, a.out + O_Y, mod + 5 * DM, 0};
              OPAQUE_TID(); pg8::gemm_phase<EpiRes>(lds, g, S, E, tq); }
            if (layer == 0) xcd_barrier(xbar);
        }
    }
}

extern "C" void kernel_launch(void* const* d_in, const int* in_sizes, int n_in, void* d_out, int out_size, void* d_ws, size_t ws_size, hipStream_t stream) {
    static int grid = 0;
    if (grid == 0) {
        if (n_in != 28 || ws_size < WS_END) { fprintf(stderr, "kernel_launch: need 28 inputs and %zu bytes of workspace (got %d, %zu)\n", (size_t)WS_END, n_in, ws_size); grid = -1; return; }
        int dev = 0, cus = 0, per_cu = 0;
        hipGetDevice(&dev);
        hipDeviceGetAttribute(&cus, hipDeviceAttributeMultiprocessorCount, dev);
        hipFuncSetAttribute((const void*)mega_fwd, hipFuncAttributeMaxDynamicSharedMemorySize, LDS_BYTES);
        hipOccupancyMaxActiveBlocksPerMultiprocessor(&per_cu, (const void*)mega_fwd, 512, LDS_BYTES);
        if (per_cu < 1) per_cu = 1;
        grid = cus;
        (void)hipGetLastError();
    }
    if (grid < 0) return;
    Args a{};
    for (int i = 0; i < 28; ++i) a.in[i] = (const float*)d_in[i];
    a.out = (float*)d_out; a.ws = (unsigned char*)d_ws;
    void* args[] = {&a};
    hipError_t e = hipLaunchCooperativeKernel((const void*)mega_fwd, dim3(grid), dim3(512), args, LDS_BYTES, stream);
    if (e != hipSuccess) fprintf(stderr, "cooperative launch failed: %s (grid %d)\n", hipGetErrorString(e), grid);
}
```
